# Optimizing an MI355X kernel written in HIP

```python
import math
import jax, jax.numpy as jnp
from jax import lax
import numpy as np

D_MODEL = 1024
BATCH = 8
SEQ = 2048
DEPTH = 2

HEAD_DIM = 64
FOX_HEADS = 8
DIFF_HEADS = 4
FOX_WIDTH = FOX_HEADS * HEAD_DIM
DIFF_WIDTH = DIFF_HEADS * 2 * HEAD_DIM
MIX_WIDTH = FOX_WIDTH + DIFF_WIDTH
IN_WIDTH = 3 * FOX_WIDTH + FOX_HEADS + 3 * DIFF_WIDTH
D_FF = ((8 * D_MODEL // 3 + 255) // 256) * 256
BLOCK_Q = 128
EPS = 1e-6

kernel_name = "fox_diffattn_hybrid_adaln"


def _rms(x, g):
    xf = x.astype(jnp.float32)
    y = xf * lax.rsqrt(jnp.mean(xf * xf, axis=-1, keepdims=True) + EPS)
    return (y * g.astype(jnp.float32)).astype(x.dtype)


def _to_blocks(t):
    b, h, s = t.shape[:3]
    nb = s // BLOCK_Q
    t = t.reshape((b, h, nb, BLOCK_Q) + t.shape[3:])
    return jnp.moveaxis(t, 2, 0)


def _from_blocks(t):
    nb, b, h, bq, d = t.shape
    return jnp.moveaxis(t, 0, 2).reshape(b, h, nb * bq, d)


def _fox_attention(q, k, v, log_f):
    s_len = q.shape[2]
    scale = 1.0 / math.sqrt(q.shape[-1])
    cum = jnp.cumsum(log_f, axis=-1)
    key_pos = jnp.arange(s_len)
    starts = jnp.arange(s_len // BLOCK_Q) * BLOCK_Q

    def one_block(args):
        qi, ci, st = args
        s = jnp.einsum('bhqd,bhkd->bhqk', qi, k, preferred_element_type=jnp.float32) * scale
        s = s + ci[..., :, None] - cum[..., None, :]
        qpos = st + jnp.arange(BLOCK_Q)
        mask = key_pos[None, :] <= qpos[:, None]
        p = jax.nn.softmax(jnp.where(mask, s, -jnp.inf), axis=-1)
        return jnp.einsum('bhqk,bhkd->bhqd', p.astype(v.dtype), v)

    out = lax.map(one_block, (_to_blocks(q), _to_blocks(cum), starts))
    return _from_blocks(out)


def _diff_attention(q1, q2, k1, k2, v, lam, slopes):
    s_len = q1.shape[2]
    scale = 1.0 / math.sqrt(q1.shape[-1])
    key_pos = jnp.arange(s_len)
    starts = jnp.arange(s_len // BLOCK_Q) * BLOCK_Q

    def one_block(args):
        q1i, q2i, st = args
        qpos = st + jnp.arange(BLOCK_Q)
        dist = (qpos[:, None] - key_pos[None, :]).astype(jnp.float32)
        alibi = -slopes[:, None, None] * dist
        mask = dist >= 0
        s1 = jnp.einsum('bhqd,bhkd->bhqk', q1i, k1, preferred_element_type=jnp.float32) * scale + alibi
        s2 = jnp.einsum('bhqd,bhkd->bhqk', q2i, k2, preferred_element_type=jnp.float32) * scale + alibi
        p = (jax.nn.softmax(jnp.where(mask, s1, -jnp.inf), axis=-1)
             - lam * jax.nn.softmax(jnp.where(mask, s2, -jnp.inf), axis=-1))
        return jnp.einsum('bhqk,bhkd->bhqd', p.astype(v.dtype), v)

    out = lax.map(one_block, (_to_blocks(q1), _to_blocks(q2), starts))
    return _from_blocks(out)


def _modulate(x, g, shift, scale):
    return _rms(x, g) * (1.0 + scale[:, None, :]) + shift[:, None, :]


def setup_inputs(seed: int = 0) -> dict:
    key = jax.random.key(seed)
    ks = jax.random.split(key, 20)
    f32 = jnp.float32
    nrm = lambda k, shape, s: jax.random.normal(k, shape, f32) * s
    d = D_MODEL
    return {
        "x": nrm(ks[0], (BATCH, SEQ, d), 1.0),
        "c": nrm(ks[1], (BATCH, d), 1.0),
        "ln1_g": 1.0 + nrm(ks[2], (DEPTH, d), 0.02),
        "ln2_g": 1.0 + nrm(ks[3], (DEPTH, d), 0.02),
        "w_ada": nrm(ks[4], (DEPTH, d, 6 * d), 0.5 * d ** -0.5),
        "b_ada": nrm(ks[5], (DEPTH, 6 * d), 0.02),
        "w_in": nrm(ks[6], (DEPTH, d, IN_WIDTH), d ** -0.5),
        "b_f": 1.5 + nrm(ks[7], (DEPTH, FOX_HEADS), 0.1),
        "fox_qk_g": 1.0 + nrm(ks[8], (DEPTH, 2, HEAD_DIM), 0.02),
        "diff_qk_g": 1.0 + nrm(ks[9], (DEPTH, 2, HEAD_DIM), 0.02),
        "diff_lam": nrm(ks[10], (DEPTH, 4, HEAD_DIM), 0.1),
        "diff_norm_g": 1.0 + nrm(ks[11], (DEPTH, 2 * HEAD_DIM), 0.02),
        "w_out": nrm(ks[12], (DEPTH, MIX_WIDTH, d), MIX_WIDTH ** -0.5),
        "w_gate": nrm(ks[13], (DEPTH, d, D_FF), d ** -0.5),
        "w_up": nrm(ks[14], (DEPTH, d, D_FF), d ** -0.5),
        "w_down": nrm(ks[15], (DEPTH, D_FF, d), D_FF ** -0.5),
    }


def reference(x, c, ln1_g, ln2_g, w_ada, b_ada, w_in, b_f, fox_qk_g, diff_qk_g,
              diff_lam, diff_norm_g, w_out, w_gate, w_up, w_down):
    b, s, d = x.shape
    cond = jax.nn.silu(c)
    slopes = 2.0 ** (-8.0 * jnp.arange(1, DIFF_HEADS + 1, dtype=jnp.float32) / DIFF_HEADS)
    splits = np.cumsum([FOX_WIDTH, FOX_WIDTH, FOX_WIDTH, FOX_HEADS,
                        DIFF_WIDTH, DIFF_WIDTH]).tolist()

    for l in range(DEPTH):
        mod = cond @ w_ada[l] + b_ada[l]
        sh1, sc1, g1, sh2, sc2, g2 = jnp.split(mod, 6, axis=-1)

        h = _modulate(x, ln1_g[l], sh1, sc1)
        u = h @ w_in[l]
        fq, fk, fv, fg, dq, dk, dv = jnp.split(u, splits, axis=-1)

        heads = lambda t, n, hd: t.reshape(b, s, n, hd).transpose(0, 2, 1, 3)
        fq = _rms(heads(fq, FOX_HEADS, HEAD_DIM), fox_qk_g[l, 0])
        fk = _rms(heads(fk, FOX_HEADS, HEAD_DIM), fox_qk_g[l, 1])
        fv = heads(fv, FOX_HEADS, HEAD_DIM)
        log_f = jax.nn.log_sigmoid(fg.astype(jnp.float32) + b_f[l].astype(jnp.float32))
        log_f = log_f.transpose(0, 2, 1)
        fox_out = _fox_attention(fq, fk, fv, log_f)

        dq = dq.reshape(b, s, DIFF_HEADS, 2, HEAD_DIM).transpose(0, 2, 3, 1, 4)
        dk = dk.reshape(b, s, DIFF_HEADS, 2, HEAD_DIM).transpose(0, 2, 3, 1, 4)
        dq = _rms(dq, diff_qk_g[l, 0])
        dk = _rms(dk, diff_qk_g[l, 1])
        dv = heads(dv, DIFF_HEADS, 2 * HEAD_DIM)
        lam_init = 0.8 - 0.6 * math.exp(-0.3 * l)
        lv = diff_lam[l].astype(jnp.float32)
        lam = jnp.exp(jnp.sum(lv[0] * lv[1])) - jnp.exp(jnp.sum(lv[2] * lv[3])) + lam_init
        diff_out = _diff_attention(dq[:, :, 0], dq[:, :, 1], dk[:, :, 0], dk[:, :, 1], dv, lam, slopes)
        diff_out = _rms(diff_out, diff_norm_g[l]) * (1.0 - lam_init)

        mixed = jnp.concatenate([
            fox_out.transpose(0, 2, 1, 3).reshape(b, s, FOX_WIDTH),
            diff_out.transpose(0, 2, 1, 3).reshape(b, s, DIFF_WIDTH)], axis=-1)
        x = x + g1[:, None, :] * (mixed @ w_out[l])

        h2 = _modulate(x, ln2_g[l], sh2, sc2)
        y = (jax.nn.silu(h2 @ w_gate[l]) * (h2 @ w_up[l])) @ w_down[l]
        x = x + g2[:, None, :] * y
    return x
```

```cpp
#include <hip/hip_runtime.h>
#include <hip/hip_cooperative_groups.h>
#include <cstdio>
#include <cstdint>
namespace cg = cooperative_groups;
namespace pg8 {
#define PG8_LAS __attribute__((address_space(3)))
typedef unsigned short bf16_t;
typedef short bf16x8 __attribute__((ext_vector_type(8)));
typedef float f32x4 __attribute__((ext_vector_type(4)));
typedef unsigned u32x4 __attribute__((ext_vector_type(4)));
constexpr int BM = 256, BK = 64, HALF = 128, HTB = HALF * BK * 2  , STAGE_BYTES = 8 * HTB, NXCD = 8, WGM = 4;

__host__ __device__ __forceinline__ int lds_byte(int r, int c) { const int st = (r >> 4) * 2 + (c >> 5), rr = r & 15, cc = c & 31, ob = rr * 64 + cc * 2; return st * 1024 + (ob ^ (((ob >> 9) & 1) << 5)); }
__host__ __device__ __forceinline__ void stage_rc(int b, int& R, int& C) { const int st = b / 1024, sb = b % 1024, swz = sb ^ (((sb >> 9) & 1) << 5); R = (st >> 1) * 16 + swz / 64; C = (st & 1) * 32 + (swz % 64) / 2; }
__host__ __device__ __forceinline__ int perm32(int rho) { const int n = rho >> 4, i = rho & 15; return 8 * (i >> 2) + 4 * n + (i & 3); }

struct Unit { int pm, pn; };
struct Gemm { const bf16_t* A; const bf16_t* Bt; int M, N, K; };

struct StaticOrder {
    int nM, nN, nwg, G, c;
    __host__ __device__ void init(int M, int N, int G_, int c_) { nM = M / BM; nN = N / BM; nwg = nM * nN; G = G_; c = c_; }
    __host__ __device__ bool next(int i, Unit& u) const {
        const long L = (long)i * G + c; if (L >= nwg) return false;
        int wgid = (int)L; { const int q = nwg / NXCD, r = nwg % NXCD, xcd = wgid % NXCD, off = wgid / NXCD; wgid = (xcd < r ? xcd * (q + 1) : r * (q + 1) + (xcd - r) * q) + off; }
        const int nig = WGM * nN, gid = wgid / nig, fm = gid * WGM, gsz = (nM - fm) < WGM ? (nM - fm) : WGM;
        u.pm = fm + ((wgid % nig) % gsz); u.pn = (wgid % nig) / gsz; return true;
    }
    __device__ __forceinline__ void a_ready(const Unit&) const {}
    __device__ __forceinline__ void done(const Unit&) const {}
};

__device__ __forceinline__ unsigned cvt_pk_bf16(float lo, float hi) { unsigned r; asm volatile("v_cvt_pk_bf16_f32 %0, %1, %2" : "=v"(r) : "v"(lo), "v"(hi)); return r; }
constexpr float kLog2e = 1.4426950408889634f;
struct Prefetch {
    StaticOrder S; const float* rowss; const float* bias; int bstride; PG8_LAS unsigned char* pf;
    __device__ __forceinline__ void issue(int k, bool wave0, int lane) const {
        Unit u;
        if (wave0 && S.next(k, u)) {
            PG8_LAS unsigned char* slot = pf + (k & 1) * 5120;
#pragma unroll
            for (int q = 0; q < 4; ++q) __builtin_amdgcn_global_load_lds((const unsigned*)(rowss + (size_t)(u.pm * BM + 64 * q) * 4 + 4 * lane), (PG8_LAS unsigned*)(slot + 1024 * q), 16, 0, 0);
            __builtin_amdgcn_global_load_lds((const unsigned*)(bias + (u.pm >> 3) * bstride + u.pn * BM + 4 * lane), (PG8_LAS unsigned*)(slot + 4096), 16, 0, 0);
        }
    }
};
struct EpiIn {
    static constexpr bool PERM = true, AFTER_DRAIN = false; static constexpr int EXTRA_DMA = 5;
    bf16_t* U; const float* fox_g; const float* diff_g; Prefetch P; mutable int k;
    __device__ __forceinline__ void operator()(const f32x4 (&acc)[2][2][4][2], const Unit& u, int wr, int wc, int fr, int fq) const {
        const int seg = u.pn >> 1;
        const bool donorm = (seg != 2) && (seg != 5);
        const float* g = (seg < 3) ? fox_g + (seg == 1 ? 64 : 0) : diff_g + (seg == 4 ? 64 : 0);
        const float qs = (seg == 0 || seg == 3) ? 0.125f * kLog2e : 1.f;
        f32x4 gv[2][2], bv[2][2];
        P.issue(k + 1, wr == 0 && wc == 0, fr + 16 * fq);
        PG8_LAS const float* slot = (PG8_LAS const float*)(P.pf + (k & 1) * 5120); ++k;
        PG8_LAS const float* bp = slot + 1024 + 32 * wc + 8 * fq;
#pragma unroll
        for (int bj = 0; bj < 2; ++bj)
#pragma unroll
            for (int n = 0; n < 2; ++n) { gv[bj][n] = donorm ? (*(const f32x4*)(g + 32 * bj + 8 * fq + 4 * n)) * qs : (f32x4){1.f, 1.f, 1.f, 1.f}; bv[bj][n] = *(PG8_LAS const f32x4*)(bp + 128 * bj + 4 * n); }
        const int row0 = u.pm * BM + wr * 64 + fr, col0 = u.pn * BM + 64 * wc + 8 * fq;
        float rr[2][4];
#pragma unroll
        for (int ai = 0; ai < 2; ++ai)
#pragma unroll
            for (int m = 0; m < 4; ++m) { const f32x4 t = *(PG8_LAS const f32x4*)(slot + 4 * (wr * 64 + fr + ai * HALF + m * 16)); rr[ai][m] = (t[0] + t[1]) + (t[2] + t[3]); }
#pragma unroll
        for (int ai = 0; ai < 2; ++ai)
#pragma unroll
            for (int m = 0; m < 4; ++m) {
                const int row = row0 + ai * HALF + m * 16;
                const float r = __builtin_amdgcn_rsqf(rr[ai][m] * (1.0f / 1024.0f) + 1e-6f);
                f32x4 v[2][2];
#pragma unroll
                for (int bj = 0; bj < 2; ++bj)
#pragma unroll
                    for (int n = 0; n < 2; ++n) v[bj][n] = acc[ai][bj][m][n] * r + bv[bj][n];
                float sc = 1.f;
                if (donorm) {
                    float ss = 0.f;
#pragma unroll
                    for (int bj = 0; bj < 2; ++bj)
#pragma unroll
                        for (int n = 0; n < 2; ++n) { const f32x4 t = v[bj][n]; ss += (t[0] * t[0] + t[1] * t[1]) + (t[2] * t[2] + t[3] * t[3]); }
                    ss += __shfl_xor(ss, 16); ss += __shfl_xor(ss, 32);
                    sc = 1.0f / sqrtf(ss * (1.0f / 64.0f) + 1e-6f);
                }
                bf16_t* rowp = U + (size_t)row * 3072 + col0;
#pragma unroll
                for (int bj = 0; bj < 2; ++bj) {
                    const f32x4 v0 = v[bj][0] * gv[bj][0] * sc, v1 = v[bj][1] * gv[bj][1] * sc;
                    u32x4 w; w.x = cvt_pk_bf16(v0[0], v0[1]); w.y = cvt_pk_bf16(v0[2], v0[3]); w.z = cvt_pk_bf16(v1[0], v1[1]); w.w = cvt_pk_bf16(v1[2], v1[3]);
                    *(u32x4*)(rowp + 32 * bj) = w;
                }
            }
    }
};
struct EpiRes {
    static constexpr bool PERM = true, AFTER_DRAIN = false; static constexpr int EXTRA_DMA = 0;
    const float* xin32; const bf16_t* xin16; float* xout32; bf16_t* xout16; const float* gate; bf16_t* An; const float* gs; float* rowss_n; PG8_LAS float* red;
    template <bool IN16>
    __device__ __forceinline__ void rows(const f32x4 (&acc)[2][2][4][2], const Unit& u, int wr, int wc, int fr, int fq) const {
        const int b = u.pm >> 3, col0 = u.pn * BM + wc * 32 + 8 * fq, row0 = u.pm * BM + wr * 64 + fr;
        const bool nxt = An != nullptr, out16 = xout16 != nullptr;
        f32x4 gv[2][2], sv[2][2];
#pragma unroll
        for (int bj = 0; bj < 2; ++bj)
#pragma unroll
            for (int n = 0; n < 2; ++n) { gv[bj][n] = *(const f32x4*)(gate + b * 6144 + col0 + bj * HALF + n * 4); sv[bj][n] = nxt ? *(const f32x4*)(gs + b * 1024 + col0 + bj * HALF + n * 4) : (f32x4){0.f, 0.f, 0.f, 0.f}; }
#pragma unroll
        for (int ai = 0; ai < 2; ++ai)
#pragma unroll
            for (int m = 0; m < 4; ++m) { const int row = row0 + ai * HALF + m * 16; const size_t off = (size_t)row * 1024 + col0; float ss = 0.f;
#pragma unroll
                for (int bj = 0; bj < 2; ++bj) {
                    f32x4 xa, xb;
                    if (IN16) { const u32x4 w = __builtin_nontemporal_load((const u32x4*)(xin16 + off + bj * HALF));
                        xa = (f32x4){__builtin_bit_cast(float, w.x << 16), __builtin_bit_cast(float, w.x & 0xffff0000u), __builtin_bit_cast(float, w.y << 16), __builtin_bit_cast(float, w.y & 0xffff0000u)};
                        xb = (f32x4){__builtin_bit_cast(float, w.z << 16), __builtin_bit_cast(float, w.z & 0xffff0000u), __builtin_bit_cast(float, w.w << 16), __builtin_bit_cast(float, w.w & 0xffff0000u)}; }
                    else { xa = __builtin_nontemporal_load((const f32x4*)(xin32 + off + bj * HALF)); xb = __builtin_nontemporal_load((const f32x4*)(xin32 + off + bj * HALF + 4)); }
                    const f32x4 x0 = xa + gv[bj][0] * acc[ai][bj][m][0], x1 = xb + gv[bj][1] * acc[ai][bj][m][1];
                    if (out16) { u32x4 w; w.x = cvt_pk_bf16(x0[0], x0[1]); w.y = cvt_pk_bf16(x0[2], x0[3]); w.z = cvt_pk_bf16(x1[0], x1[1]); w.w = cvt_pk_bf16(x1[2], x1[3]); *(u32x4*)(xout16 + off + bj * HALF) = w; }
                    else { *(f32x4*)(xout32 + off + bj * HALF) = x0; *(f32x4*)(xout32 + off + bj * HALF + 4) = x1; }
                    if (nxt) { const f32x4 t0 = x0 * sv[bj][0], t1 = x1 * sv[bj][1];
                        u32x4 w; w.x = cvt_pk_bf16(t0[0], t0[1]); w.y = cvt_pk_bf16(t0[2], t0[3]); w.z = cvt_pk_bf16(t1[0], t1[1]); w.w = cvt_pk_bf16(t1[2], t1[3]);
                        *(u32x4*)(An + off + bj * HALF) = w;
                        ss += ((x0[0] * x0[0] + x0[1] * x0[1]) + (x0[2] * x0[2] + x0[3] * x0[3])) + ((x1[0] * x1[0] + x1[1] * x1[1]) + (x1[2] * x1[2] + x1[3] * x1[3])); } }
                if (nxt) { ss += __shfl_xor(ss, 16); ss += __shfl_xor(ss, 32); if (fq == 0) red[wc * 256 + wr * 64 + ai * HALF + m * 16 + fr] = ss; }
                if (!IN16 && m == 3) asm volatile("" ::: "memory"); }
    }
    __device__ __forceinline__ void operator()(const f32x4 (&acc)[2][2][4][2], const Unit& u, int wr, int wc, int fr, int fq) const {
        if (xin16 != nullptr) rows<true>(acc, u, wr, wc, fr, fq); else rows<false>(acc, u, wr, wc, fr, fq);
        if (An != nullptr) {
            asm volatile("s_waitcnt lgkmcnt(0)\n\ts_barrier" ::: "memory");
            const int t = (wr * 4 + wc) * 64 + fq * 16 + fr;
            if (t < 256) rowss_n[(size_t)(u.pm * BM + t) * 4 + u.pn] = (red[t] + red[256 + t]) + (red[512 + t] + red[768 + t]);
            asm volatile("s_waitcnt lgkmcnt(0)\n\ts_barrier" ::: "memory");
        }
    }
};
struct EpiGU {
    static constexpr bool PERM = true, AFTER_DRAIN = false; static constexpr int EXTRA_DMA = 5;
    bf16_t* Aout; Prefetch P; mutable int k;
    __device__ __forceinline__ float silu(float x) const { return x * __builtin_amdgcn_rcpf(1.0f + __builtin_amdgcn_exp2f(-x * kLog2e)); }
    __device__ __forceinline__ void operator()(const f32x4 (&acc)[2][2][4][2], const Unit& u, int wr, int wc, int fr, int fq) const {
        const int row0 = u.pm * BM + wr * 64 + fr, col0 = u.pn * 128 + 32 * wc + 8 * fq;
        P.issue(k + 1, wr == 0 && wc == 0, fr + 16 * fq);
        PG8_LAS const float* slot = (PG8_LAS const float*)(P.pf + (k & 1) * 5120); ++k;
        PG8_LAS const float* bp = slot + 1024 + 32 * wc + 8 * fq;
        const f32x4 bg0 = *(PG8_LAS const f32x4*)(bp), bg1 = *(PG8_LAS const f32x4*)(bp + 4), bu0 = *(PG8_LAS const f32x4*)(bp + 128), bu1 = *(PG8_LAS const f32x4*)(bp + 132);
        float rr[2][4];
#pragma unroll
        for (int ai = 0; ai < 2; ++ai)
#pragma unroll
            for (int m = 0; m < 4; ++m) { const f32x4 t = *(PG8_LAS const f32x4*)(slot + 4 * (wr * 64 + fr + ai * HALF + m * 16)); rr[ai][m] = (t[0] + t[1]) + (t[2] + t[3]); }
#pragma unroll
        for (int ai = 0; ai < 2; ++ai)
#pragma unroll
            for (int m = 0; m < 4; ++m) {
                const int row = row0 + ai * HALF + m * 16;
                const float r = __builtin_amdgcn_rsqf(rr[ai][m] * (1.0f / 1024.0f) + 1e-6f);
                const f32x4 g0 = acc[ai][0][m][0] * r + bg0, g1 = acc[ai][0][m][1] * r + bg1, u0 = acc[ai][1][m][0] * r + bu0, u1 = acc[ai][1][m][1] * r + bu1;
                u32x4 w; w.x = cvt_pk_bf16(silu(g0[0]) * u0[0], silu(g0[1]) * u0[1]); w.y = cvt_pk_bf16(silu(g0[2]) * u0[2], silu(g0[3]) * u0[3]);
                w.z = cvt_pk_bf16(silu(g1[0]) * u1[0], silu(g1[1]) * u1[1]); w.w = cvt_pk_bf16(silu(g1[2]) * u1[2], silu(g1[3]) * u1[3]);
                *(u32x4*)(Aout + (size_t)row * 2816 + col0) = w;
            }
    }
};

template <class Epi, class Sched, bool ALIGN_EPI = false, bool SP2 = false>
__device__ __forceinline__ void gemm_phase(PG8_LAS unsigned char* lds, const Gemm g, const Sched& S, const Epi& E, const int tid) {
    const int wid = __builtin_amdgcn_readfirstlane(tid >> 6), lane = tid & 63, wr = wid >> 2, wc = wid & 3, fr = lane & 15, fq = lane >> 4;
    const int K = g.K, nt = K / BK;
    unsigned voffA[2], voffB[2];
#pragma unroll
    for (int i = 0; i < 2; ++i) { int R, C; stage_rc(tid * 16 + i * 8192, R, C); const int Rb = Epi::PERM ? ((R & ~31) + perm32(R & 31)) : R;
        voffA[i] = (unsigned)(R * K + C) * 2u; voffB[i] = (unsigned)(Rb * K + C) * 2u; }
    const size_t kstep = (size_t)(BK * 2);
    const size_t hstep = (size_t)HALF * K * 2;
    const size_t tstep = 2 * hstep;
    const unsigned ldsw = (unsigned)wid * 1024u;
    const int aoff = lds_byte(wr * 64 + fr, fq * 8), boff = lds_byte(wc * 32 + fr, fq * 8);
#define PG8_SA(b, h) (((b) * 2 + (h)) * HTB)
#define PG8_SB(b, h) ((4 + (b) * 2 + (h)) * HTB)
#define PG8_STAGE(bufoff, gbase, voff) do { _Pragma("unroll") for (int _i = 0; _i < 2; ++_i) \
        __builtin_amdgcn_global_load_lds((const unsigned*)((const char*)(gbase) + (voff)[_i]), (PG8_LAS unsigned*)(lds + (bufoff) + ldsw + _i * 8192), 16, 0, 0); } while (0)
#define PG8_LDA(dst, b, h) do { _Pragma("unroll") for (int m = 0; m < 4; ++m) _Pragma("unroll") for (int k = 0; k < 2; ++k) dst[m][k] = *(const PG8_LAS bf16x8*)(lds + PG8_SA(b, h) + aoff + m * 2048 + k * 1024); } while (0)
#define PG8_LDB(dst, b, h) do { _Pragma("unroll") for (int n = 0; n < 2; ++n) _Pragma("unroll") for (int k = 0; k < 2; ++k) dst[n][k] = *(const PG8_LAS bf16x8*)(lds + PG8_SB(b, h) + boff + n * 2048 + k * 1024); } while (0)
#define PG8_MMA(ai, bj, At, Bt) do { __builtin_amdgcn_s_setprio(1); _Pragma("unroll") for (int m = 0; m < 4; ++m) _Pragma("unroll") for (int n = 0; n < 2; ++n) _Pragma("unroll") for (int k = 0; k < 2; ++k) \
        acc[ai][bj][m][n] = __builtin_amdgcn_mfma_f32_16x16x32_bf16(Bt[n][k], At[m][k], acc[ai][bj][m][n], 0, 0, 0); __builtin_amdgcn_s_setprio(0); } while (0)
#define PG8_WAIT_V(n) asm volatile("s_waitcnt vmcnt(" #n ")" ::: "memory")
#define PG8_WAIT_L(n) asm volatile("s_waitcnt lgkmcnt(" #n ")" ::: "memory")
#define PG8_BAR __builtin_amdgcn_s_barrier()
#define PG8_SCHED __builtin_amdgcn_sched_barrier(0)
    Unit cur, nxt; int ui = 0;
    if (!S.next(0, cur)) return;
    f32x4 acc[2][2][4][2];
#pragma unroll
    for (int a = 0; a < 2; ++a)
#pragma unroll
        for (int b = 0; b < 2; ++b)
#pragma unroll
            for (int m = 0; m < 4; ++m)
#pragma unroll
                for (int n = 0; n < 2; ++n) acc[a][b][m][n] = (f32x4){0.f, 0.f, 0.f, 0.f};
    bf16x8 At[4][2], B0[2][2], B1[2][2];
    const char* cA = (const char*)g.A + (size_t)cur.pm * tstep; const char* cB = (const char*)g.Bt + (size_t)cur.pn * tstep;
    S.a_ready(cur);
    if constexpr (SP2) {
        PG8_STAGE(PG8_SB(0, 0), cB, voffB); PG8_STAGE(PG8_SB(0, 1), cB + hstep, voffB); PG8_STAGE(PG8_SA(0, 0), cA, voffA); PG8_STAGE(PG8_SA(0, 1), cA + hstep, voffA);
        if (wr == 1) PG8_BAR;
        PG8_WAIT_V(2); PG8_BAR;
        PG8_STAGE(PG8_SB(1, 0), cB + kstep, voffB); PG8_STAGE(PG8_SA(1, 0), cA + kstep, voffA); PG8_STAGE(PG8_SB(1, 1), cB + hstep + kstep, voffB);
        PG8_WAIT_V(6); PG8_BAR;
    } else {
        PG8_STAGE(PG8_SB(0, 0), cB, voffB); PG8_STAGE(PG8_SA(0, 0), cA, voffA); PG8_STAGE(PG8_SB(0, 1), cB + hstep, voffB); PG8_STAGE(PG8_SA(0, 1), cA + hstep, voffA);
        if (wr == 1) PG8_BAR;
        PG8_WAIT_V(4); PG8_BAR;
        PG8_STAGE(PG8_SB(1, 0), cB + kstep, voffB); PG8_STAGE(PG8_SA(1, 0), cA + kstep, voffA); PG8_STAGE(PG8_SB(1, 1), cB + hstep + kstep, voffB);
        PG8_WAIT_V(6); PG8_BAR;
    }
    for (;;) {
        const bool has_next = S.next(ui + 1, nxt);
        const char* nA = has_next ? (const char*)g.A + (size_t)nxt.pm * tstep : cA; const char* nB = has_next ? (const char*)g.Bt + (size_t)nxt.pn * tstep : cB;
        for (int t = 0; t < nt; t += 2) {
            const bool last = (t == nt - 2);
            const char* a1 = cA + (size_t)(t + 1) * kstep;
            const char* a2 = last ? nA : cA + (size_t)(t + 2) * kstep; const char* b2 = last ? nB : cB + (size_t)(t + 2) * kstep;
            const char* a3 = a2 + kstep; const char* b3 = b2 + kstep;
            if (last && has_next) S.a_ready(nxt);
            if constexpr (SP2) {
            PG8_LDB(B0, 0, 0); PG8_LDB(B1, 0, 1); PG8_SCHED; PG8_LDA(At, 0, 0); PG8_STAGE(PG8_SA(1, 1), a1 + hstep, voffA);
            PG8_WAIT_V(8); PG8_WAIT_L(0); PG8_BAR; PG8_MMA(0, 0, At, B0); PG8_MMA(0, 1, At, B1); PG8_BAR; PG8_SCHED;
            PG8_LDA(At, 0, 1); PG8_STAGE(PG8_SB(0, 0), b2, voffB); PG8_STAGE(PG8_SB(0, 1), b2 + hstep, voffB); PG8_STAGE(PG8_SA(0, 0), a2, voffA);
            PG8_WAIT_V(8); PG8_WAIT_L(0); PG8_BAR; PG8_MMA(1, 0, At, B0); PG8_MMA(1, 1, At, B1); PG8_BAR; PG8_SCHED;
            PG8_LDB(B0, 1, 0); PG8_LDB(B1, 1, 1); PG8_SCHED; PG8_LDA(At, 1, 0); PG8_STAGE(PG8_SA(0, 1), a2 + hstep, voffA);
            PG8_WAIT_V(8); PG8_WAIT_L(0); PG8_BAR; PG8_MMA(0, 0, At, B0); PG8_MMA(0, 1, At, B1); PG8_BAR; PG8_SCHED;
            PG8_LDA(At, 1, 1); PG8_STAGE(PG8_SB(1, 0), b3, voffB); PG8_STAGE(PG8_SB(1, 1), b3 + hstep, voffB); PG8_STAGE(PG8_SA(1, 0), a3, voffA);
            PG8_WAIT_V(8); PG8_WAIT_L(0); PG8_BAR; PG8_MMA(1, 0, At, B0); PG8_MMA(1, 1, At, B1); PG8_BAR; PG8_SCHED;
            } else {
            PG8_LDB(B0, 0, 0); PG8_SCHED; PG8_LDA(At, 0, 0); PG8_STAGE(PG8_SA(1, 1), a1 + hstep, voffA);
            PG8_WAIT_L(8); PG8_BAR; PG8_WAIT_L(0); PG8_MMA(0, 0, At, B0); PG8_BAR; PG8_SCHED;
            PG8_LDB(B1, 0, 1); PG8_STAGE(PG8_SB(0, 0), b2, voffB);
            PG8_BAR; PG8_WAIT_L(0); PG8_MMA(0, 1, At, B1); PG8_BAR;
            PG8_LDA(At, 0, 1); PG8_STAGE(PG8_SA(0, 0), a2, voffA);
            PG8_BAR; PG8_WAIT_L(0); PG8_MMA(1, 0, At, B0); PG8_BAR; PG8_SCHED;
            PG8_STAGE(PG8_SB(0, 1), b2 + hstep, voffB);
            PG8_WAIT_V(6); PG8_BAR; PG8_MMA(1, 1, At, B1); PG8_BAR;
            PG8_LDB(B0, 1, 0); PG8_SCHED; PG8_LDA(At, 1, 0); PG8_STAGE(PG8_SA(0, 1), a2 + hstep, voffA);
            PG8_WAIT_L(8); PG8_BAR; PG8_WAIT_L(0); PG8_MMA(0, 0, At, B0); PG8_BAR; PG8_SCHED;
            PG8_LDB(B1, 1, 1); PG8_STAGE(PG8_SB(1, 0), b3, voffB);
            PG8_BAR; PG8_WAIT_L(0); PG8_MMA(0, 1, At, B1); PG8_BAR;
            PG8_LDA(At, 1, 1); PG8_STAGE(PG8_SA(1, 0), a3, voffA);
            PG8_BAR; PG8_WAIT_L(0); PG8_MMA(1, 0, At, B0); PG8_BAR; PG8_SCHED;
            PG8_STAGE(PG8_SB(1, 1), b3 + hstep, voffB);
            PG8_WAIT_V(6); PG8_BAR; PG8_MMA(1, 1, At, B1); PG8_BAR;
            }
        }
        if constexpr (ALIGN_EPI) { if (wr == 0) PG8_BAR; }
        if constexpr (!Epi::AFTER_DRAIN) { E(acc, cur, wr, wc, fr, fq); S.done(cur); }
        if (!has_next) break;
#pragma unroll
        for (int a = 0; a < 2; ++a)
#pragma unroll
            for (int b = 0; b < 2; ++b)
#pragma unroll
                for (int m = 0; m < 4; ++m)
#pragma unroll
                    for (int n = 0; n < 2; ++n) acc[a][b][m][n] = (f32x4){0.f, 0.f, 0.f, 0.f};
        cur = nxt; cA = nA; cB = nB; ++ui;
        if constexpr (ALIGN_EPI) { if (wr == 1) PG8_BAR; }
    }
    PG8_WAIT_V(0);
    if constexpr (!ALIGN_EPI) { if (wr == 0) PG8_BAR; }
    PG8_BAR;
    if constexpr (Epi::AFTER_DRAIN) { E.fused(acc, cur, wr, wc, fr, fq, lds, wid, lane); S.done(cur); }
#undef PG8_SA
#undef PG8_SB
#undef PG8_STAGE
#undef PG8_LDA
#undef PG8_LDB
#undef PG8_MMA
#undef PG8_WAIT_V
#undef PG8_WAIT_L
#undef PG8_BAR
#undef PG8_SCHED
}
}
#define LAS __attribute__((address_space(3)))
typedef unsigned short bf16_t;
typedef short bf16x8 __attribute__((ext_vector_type(8)));
typedef short s16x4 __attribute__((ext_vector_type(4)));
typedef float f32x4 __attribute__((ext_vector_type(4)));
typedef float f32x16 __attribute__((ext_vector_type(16)));
typedef unsigned u32x4 __attribute__((ext_vector_type(4)));
typedef unsigned u32x2 __attribute__((ext_vector_type(2)));

constexpr int NB = 8, SEQ = 2048, DM = 1024, MT = NB * SEQ, DEPTH = 2, INW = 3080, UW = 3072, FF = 2816, MODW = 6144;
constexpr float EPS = 1e-6f, LOG2E = 1.4426950408889634f;
constexpr size_t MiB = 1u << 20;
constexpr size_t WS_CTR = 0, WS_MOD = 1 * MiB, WS_LOGF = 2 * MiB, WS_WIN = 4 * MiB, WS_WOUT = 16 * MiB, WS_WGU = 20 * MiB, WS_WD = 42 * MiB, WS_H = 54 * MiB, WS_U = 86 * MiB, WS_MIX = 182 * MiB, WS_SHW1 = 216 * MiB, WS_SHW2 = 217 * MiB, WS_GS = 218 * MiB, WS_XB = 220 * MiB, WS_END = 252 * MiB;
constexpr size_t WS_ROWSS = 3 * MiB, CTL_ZERO_BYTES = 65536, WS_WFGT = 2 * MiB + 512 * 1024;
constexpr int LDS_BYTES = 131072 + 2 * 5120 + 4096 + 1024, PF_OFF = 131072, RED_OFF = 131072 + 2 * 5120;
constexpr int NPHASE = 2 + 5 * DEPTH;

struct Args { const float* in[16]; float* out; unsigned char* ws; int ph_lo, ph_hi, probe, pad; };

__device__ __forceinline__ float wave_sum(float v) {
#pragma unroll
    for (int o = 1; o < 64; o <<= 1) v += __shfl_xor(v, o);
    return v;
}
__device__ __forceinline__ unsigned pk_bf16(float lo, float hi) { return pg8::cvt_pk_bf16(lo, hi); }

__device__ __forceinline__ float reduce8(const float (&d)[8], int lane) {
    const bool h32 = (lane & 32) != 0, h16 = (lane & 16) != 0, h8 = (lane & 8) != 0;
    float e[4];
#pragma unroll
    for (int i = 0; i < 4; ++i) { const float snd = h32 ? d[i] : d[4 + i], kp = h32 ? d[4 + i] : d[i]; e[i] = kp + __shfl_xor(snd, 32); }
    float f[2];
#pragma unroll
    for (int i = 0; i < 2; ++i) { const float snd = h16 ? e[i] : e[2 + i], kp = h16 ? e[2 + i] : e[i]; f[i] = kp + __shfl_xor(snd, 16); }
    const float snd = h8 ? f[0] : f[1], kp = h8 ? f[1] : f[0];
    float g = kp + __shfl_xor(snd, 8);
    g += __shfl_xor(g, 4); g += __shfl_xor(g, 2); g += __shfl_xor(g, 1);
    return g;
}

__device__ __forceinline__ void weight_items(const Args& a, LAS unsigned char* lds, const int tid, const int sel) {
    unsigned char* ws = a.ws;
    {
        LAS float* tile = (LAS float*)lds;
        volatile LAS unsigned* nx = (volatile LAS unsigned*)(lds + 64 * 260 * 4);
        unsigned* qctr = (unsigned*)(ws + WS_CTR) + 8 + sel;
        constexpr int PER_L = 192 + 64 + 352 + 176; const int NIT = sel == 0 ? PER_L + 192 + 352 : 64 + 176;
        const int c4 = tid & 63, r0 = tid >> 6;
        f32x4 v[8];
        const float* src = nullptr; size_t ld = 0; bf16_t* dst = nullptr; int K = 0, k0 = 0, mode = 0;
#define PREP_DECODE(it_) do { int r = (int)(it_), l = 0; if (sel == 0) { if (r >= PER_L) { r -= PER_L; l = 1; if (r >= 192) r += 64; } } else { l = 1; r = r < 64 ? 192 + r : 608 + (r - 64); } int pn, kb; mode = 0; \
            if (r < 192) { pn = r % 12; kb = r / 12; src = a.in[6] + (size_t)l * 1024 * INW + 256 * pn + (pn >= 6 ? 8 : 0) + 4 * c4; ld = INW; K = 1024; mode = 1; dst = (bf16_t*)(ws + WS_WIN) + (size_t)l * UW * 1024 + (size_t)(256 * pn) * 1024; } \
            else if (r < 256) { r -= 192; pn = r % 4; kb = r / 4; src = a.in[12] + (size_t)l * 1024 * 1024 + 256 * pn + 4 * c4; ld = 1024; K = 1024; dst = (bf16_t*)(ws + WS_WOUT) + (size_t)l * 1024 * 1024 + (size_t)(256 * pn) * 1024; } \
            else if (r < 608) { r -= 256; pn = r % 22; kb = r / 22; src = ((c4 >> 5) ? a.in[14] : a.in[13]) + (size_t)l * 1024 * FF + 128 * pn + 4 * (c4 & 31); ld = FF; K = 1024; dst = (bf16_t*)(ws + WS_WGU) + (size_t)l * 2 * FF * 1024 + (size_t)(256 * pn) * 1024; } \
            else { r -= 608; pn = r % 4; kb = r / 4; src = a.in[15] + (size_t)l * FF * 1024 + 256 * pn + 4 * c4; ld = 1024; K = FF; dst = (bf16_t*)(ws + WS_WD) + (size_t)l * 1024 * FF + (size_t)(256 * pn) * FF; } \
            k0 = 64 * kb; } while (0)
#define PREP_LOAD() do { _Pragma("unroll") for (int i = 0; i < 8; ++i) v[i] = __builtin_nontemporal_load((const f32x4*)(src + (size_t)(k0 + r0 + 8 * i) * ld)); } while (0)
        if (tid == 0) *nx = atomicAdd(qctr, 1u);
        __syncthreads();
        unsigned it = *nx;
        if (it < (unsigned)NIT) { PREP_DECODE(it); PREP_LOAD(); }
        while (it < (unsigned)NIT) {
            __syncthreads();
            if (tid == 0) *nx = atomicAdd(qctr, 1u);
#pragma unroll
            for (int i = 0; i < 8; ++i) *(LAS f32x4*)(tile + (r0 + 8 * i) * 260 + 4 * c4) = v[i];
            bf16_t* cdst = dst; const int cK = K, ck0 = k0, cmode = mode;
            __syncthreads();
            const unsigned nit = *nx;
            if (nit < (unsigned)NIT) { PREP_DECODE(nit); PREP_LOAD(); }
            {
                const int p = tid & 255, half = tid >> 8;
                const int ns = cmode ? (64 * ((p >> 5) & 3) + 32 * (p >> 7) + (p & 31)) : p;
                const LAS float* sp = tile + (32 * half) * 260 + ns;
                bf16_t* dp = cdst + (size_t)p * cK + ck0 + 32 * half;
#pragma unroll
                for (int q = 0; q < 4; ++q) {
                    u32x4 o; o.x = pk_bf16(sp[(8 * q) * 260], sp[(8 * q + 1) * 260]); o.y = pk_bf16(sp[(8 * q + 2) * 260], sp[(8 * q + 3) * 260]);
                    o.z = pk_bf16(sp[(8 * q + 4) * 260], sp[(8 * q + 5) * 260]); o.w = pk_bf16(sp[(8 * q + 6) * 260], sp[(8 * q + 7) * 260]);
                    *(u32x4*)(dp + 8 * q) = o;
                }
            }
            it = nit;
        }
#undef PREP_DECODE
#undef PREP_LOAD
    }
    __syncthreads();
}

__device__ __forceinline__ void prep_phase(const Args& a, LAS unsigned char* lds, const int tid) {
    unsigned char* ws = a.ws;
    const int lane = tid & 63, wid = tid >> 6;
    if ((int)blockIdx.x < 96) {
        typedef float f32x2v __attribute__((ext_vector_type(2)));
        LAS float* condT = (LAS float*)lds;
        LAS float* red = (LAS float*)(lds + 32768);
        const int task = blockIdx.x, l = task / 48, cb = task % 48;
        for (int i = tid; i < 8192; i += 512) { const int b = i >> 10, k = i & 1023; const float v = a.in[1][b * 1024 + k]; condT[k * 8 + b] = v / (1.0f + __expf(-v)); }
        __syncthreads();
        const float* wp = a.in[4] + (size_t)l * 1024 * MODW + (size_t)(128 * wid) * MODW + 128 * cb + 2 * lane;
        f32x2v acc[8];
#pragma unroll
        for (int b = 0; b < 8; ++b) acc[b] = (f32x2v){0.f, 0.f};
#pragma unroll 32
        for (int k = 0; k < 128; ++k) {
            const f32x2v w = __builtin_nontemporal_load((const f32x2v*)(wp + (size_t)k * MODW));
            const f32x4 c0 = *(const LAS f32x4*)(condT + (128 * wid + k) * 8), c1 = *(const LAS f32x4*)(condT + (128 * wid + k) * 8 + 4);
            acc[0] += w * c0[0]; acc[1] += w * c0[1]; acc[2] += w * c0[2]; acc[3] += w * c0[3];
            acc[4] += w * c1[0]; acc[5] += w * c1[1]; acc[6] += w * c1[2]; acc[7] += w * c1[3];
        }
#pragma unroll
        for (int b = 0; b < 8; ++b) *(LAS f32x2v*)(red + (wid * 8 + b) * 128 + 2 * lane) = acc[b];
        __syncthreads();
#pragma unroll
        for (int j = 0; j < 2; ++j) {
            const int o = tid + 512 * j, b = o >> 7, c = o & 127; float sum = 0.f;
#pragma unroll
            for (int w = 0; w < 8; ++w) sum += red[(w * 8 + b) * 128 + c];
            ((float*)(ws + WS_MOD))[(size_t)(l * 8 + b) * MODW + 128 * cb + c] = sum + a.in[5][l * MODW + 128 * cb + c];
        }
        __syncthreads();
    }
    for (int idx = blockIdx.x * 512 + tid; idx < 2 * 8192; idx += gridDim.x * 512) {
        const int l = idx >> 13, k = (idx >> 3) & 1023, j = idx & 7;
        ((float*)(ws + WS_WFGT))[(size_t)l * 8192 + j * 1024 + k] = a.in[6][(size_t)l * 1024 * INW + (size_t)k * INW + 1536 + j];
    }
    weight_items(a, lds, tid, 0);
    __syncthreads();
}

__device__ __forceinline__ void shw_tables(const Args& a, int t_lo, int t_hi, int gw, int ngw, int lane) {
    unsigned char* ws = a.ws;
    const float* mod = (const float*)(ws + WS_MOD);
        for (int t = t_lo; t < t_hi; ++t) {
            const int l = t >> 1, type = t & 1, nrows = type ? 2 * FF : UW;
            const float* sh = mod + (size_t)l * 8 * MODW + (type ? 3072 : 0) + 16 * lane;
            const bf16_t* wbase = type ? (const bf16_t*)(ws + WS_WGU) + (size_t)l * 2 * FF * 1024 : (const bf16_t*)(ws + WS_WIN) + (size_t)l * UW * 1024;
            float* outp = type ? (float*)(ws + WS_SHW2) + (size_t)l * 8 * 2 * FF : (float*)(ws + WS_SHW1) + (size_t)l * 8 * UW;
            f32x4 sv[8][4];
#pragma unroll
            for (int b = 0; b < 8; ++b)
#pragma unroll
                for (int q = 0; q < 4; ++q) sv[b][q] = *(const f32x4*)(sh + (size_t)b * MODW + 4 * q);
            for (int r = gw; r < nrows; r += ngw) {
                const bf16_t* wrow = wbase + (size_t)r * 1024 + 16 * lane;
                const u32x4 w0 = *(const u32x4*)(wrow), w1 = *(const u32x4*)(wrow + 8);
                float wf[16];
#pragma unroll
                for (int i = 0; i < 4; ++i) { wf[2 * i] = __uint_as_float(w0[i] << 16); wf[2 * i + 1] = __uint_as_float(w0[i] & 0xffff0000u); wf[8 + 2 * i] = __uint_as_float(w1[i] << 16); wf[8 + 2 * i + 1] = __uint_as_float(w1[i] & 0xffff0000u); }
                float d8[8];
#pragma unroll
                for (int b = 0; b < 8; ++b) { float d = 0.f;
#pragma unroll
                    for (int q = 0; q < 4; ++q) d += (sv[b][q][0] * wf[4 * q] + sv[b][q][1] * wf[4 * q + 1]) + (sv[b][q][2] * wf[4 * q + 2] + sv[b][q][3] * wf[4 * q + 3]);
                    d8[b] = d; }
                const float tot = reduce8(d8, lane);
                if ((lane & 7) == 0) outp[(size_t)(lane >> 3) * nrows + r] = tot;
            }
        }
}

__device__ __forceinline__ void norm0_phase(const Args& a, LAS unsigned char* lds, const int tid) {
    const int lane = tid & 63, wid = tid >> 6;
    unsigned char* ws = a.ws;
    const float* mod = (const float*)(ws + WS_MOD);
    bf16_t* H = (bf16_t*)(ws + WS_H); float* rowss = (float*)(ws + WS_ROWSS);
    const int gw = blockIdx.x * 8 + wid, ngw = gridDim.x * 8;
    {
        const float* g = a.in[2];
        f32x4 gm[4];
#pragma unroll
        for (int j = 0; j < 4; ++j) gm[j] = *(const f32x4*)(g + 4 * lane + 256 * j);
        for (int chunk = gw; chunk * 8 < MT; chunk += ngw) {
            const int b = (chunk * 8) >> 11;
            f32x4 sc1[4];
#pragma unroll
            for (int j = 0; j < 4; ++j) sc1[j] = (*(const f32x4*)(mod + b * MODW + 1024 + 4 * lane + 256 * j) + 1.0f) * gm[j];
#pragma unroll 2
            for (int k = 0; k < 8; ++k) {
                const int row = chunk * 8 + k;
                const float* xr = a.in[0] + (size_t)row * DM + 4 * lane;
                f32x4 v[4]; float ss = 0.f;
#pragma unroll
                for (int j = 0; j < 4; ++j) { v[j] = __builtin_nontemporal_load((const f32x4*)(xr + 256 * j)); ss += (v[j][0] * v[j][0] + v[j][1] * v[j][1]) + (v[j][2] * v[j][2] + v[j][3] * v[j][3]); }
                ss = wave_sum(ss);
                if (lane == 0) *(f32x4*)(rowss + (size_t)row * 4) = (f32x4){ss, 0.f, 0.f, 0.f};
                bf16_t* hr = H + (size_t)row * DM + 4 * lane;
#pragma unroll
                for (int j = 0; j < 4; ++j) {
                    const f32x4 t = v[j] * sc1[j];
                    u32x2 o; o.x = pk_bf16(t[0], t[1]); o.y = pk_bf16(t[2], t[3]);
                    *(u32x2*)(hr + 256 * j) = o;
                }
            }
        }
    }
    {
        float* gs = (float*)(ws + WS_GS);
        for (int idx = blockIdx.x * 512 + tid; idx < 4 * 8 * 1024; idx += gridDim.x * 512) {
            const int inst = idx >> 13, b = (idx >> 10) & 7, col = idx & 1023, l = inst >> 1, which = inst & 1;
            const float g = (which ? a.in[3] : a.in[2])[l * DM + col], sc = mod[(size_t)(l * 8 + b) * MODW + (which ? 4096 : 1024) + col];
            gs[idx] = g * (1.0f + sc);
        }
    }
    shw_tables(a, 0, 2, gw, ngw, lane);
}
__device__ __forceinline__ void fg_tail(const Args& a, int l, LAS unsigned char* lds, const int tid) {
    const int lane = tid & 63, wid = tid >> 6;
    unsigned char* ws = a.ws;
    LAS f32x4* wl = (LAS f32x4*)lds;
    {
        const f32x4* wsrc = (const f32x4*)((const float*)(ws + WS_WFGT) + (size_t)l * 8192);
#pragma unroll
        for (int i = 0; i < 4; ++i) { const int idx = tid + 512 * i, j = idx >> 8, k4 = idx & 255, ln = k4 >> 2, q = k4 & 3; wl[(j * 4 + q) * 64 + ln] = wsrc[idx]; }
    }
    __syncthreads();
    const bf16_t* H = (const bf16_t*)(ws + WS_H); const float* rowss = (const float*)(ws + WS_ROWSS) + (size_t)(2 * l) * MT * 4;
    const float* mod = (const float*)(ws + WS_MOD) + (size_t)l * 8 * MODW; float* logf = (float*)(ws + WS_LOGF);
    const float bfv = a.in[7][l * 8 + (lane >> 3)];
    for (int chunk = blockIdx.x * 8 + wid; chunk * 8 < MT; chunk += gridDim.x * 8) {
        const int rowc = chunk * 8, b = rowc >> 11;
        f32x4 sh[4];
#pragma unroll
        for (int q = 0; q < 4; ++q) sh[q] = *(const f32x4*)(mod + (size_t)b * MODW + 16 * lane + 4 * q);
#pragma unroll 1
        for (int jb = 0; jb < 8; jb += 4) {
            f32x4 rs4v[4]; u32x4 w0v[4], w1v[4];
#pragma unroll
            for (int j = 0; j < 4; ++j) { const int row = rowc + jb + j; rs4v[j] = *(const f32x4*)(rowss + (size_t)row * 4); w0v[j] = __builtin_nontemporal_load((const u32x4*)(H + (size_t)row * DM + 16 * lane)); w1v[j] = __builtin_nontemporal_load((const u32x4*)(H + (size_t)row * DM + 16 * lane + 8)); }
#pragma unroll
            for (int j = 0; j < 4; ++j) {
                const int row = rowc + jb + j;
                const f32x4 rs4 = rs4v[j]; const u32x4 w0 = w0v[j], w1 = w1v[j];
                const float r = 1.0f / sqrtf(((rs4[0] + rs4[1]) + (rs4[2] + rs4[3])) * (1.0f / 1024.0f) + EPS);
                float h[16];
#pragma unroll
                for (int i = 0; i < 4; ++i) { h[2 * i] = __uint_as_float(w0[i] << 16); h[2 * i + 1] = __uint_as_float(w0[i] & 0xffff0000u); h[8 + 2 * i] = __uint_as_float(w1[i] << 16); h[8 + 2 * i + 1] = __uint_as_float(w1[i] & 0xffff0000u); }
#pragma unroll
                for (int q = 0; q < 4; ++q) { h[4 * q] = h[4 * q] * r + sh[q][0]; h[4 * q + 1] = h[4 * q + 1] * r + sh[q][1]; h[4 * q + 2] = h[4 * q + 2] * r + sh[q][2]; h[4 * q + 3] = h[4 * q + 3] * r + sh[q][3]; }
                float d8[8];
#pragma unroll
                for (int j8 = 0; j8 < 8; ++j8) { float acc = 0.f;
#pragma unroll
                    for (int q = 0; q < 4; ++q) { const f32x4 w = wl[(j8 * 4 + q) * 64 + lane]; acc += (h[4 * q] * w[0] + h[4 * q + 1] * w[1]) + (h[4 * q + 2] * w[2] + h[4 * q + 3] * w[3]); }
                    d8[j8] = acc; }
                const float tot = reduce8(d8, lane);
                if ((lane & 7) == 0) { const float z = tot + bfv; logf[(size_t)row * 8 + (lane >> 3)] = fminf(z, 0.f) - log1pf(__expf(-fabsf(z))); }
            }
        }
    }
    __syncthreads();
}

constexpr int AT_BIAS = 0, AT_SCAN = 8192, AT_NEXT = 8192 + 64, AT_K = 8448, AT_KT = 8 * 1056;
__device__ __forceinline__ s16x4 vtr(const LAS unsigned char* p) { typedef short v4i16_t __attribute__((ext_vector_type(4))); return __builtin_bit_cast(s16x4, __builtin_amdgcn_ds_read_tr16_b64_v4i16((LAS v4i16_t*)p)); }

__device__ __forceinline__ void glds16(const void* gsrc, unsigned lds_dst) { unsigned keep;
    asm volatile("s_mov_b32 %0, m0\n\ts_mov_b32 m0, %2\n\ts_nop 0\n\tglobal_load_lds_dwordx4 %1, off\n\ts_mov_b32 m0, %0" : "=&s"(keep) : "v"(gsrc), "s"(lds_dst) : "memory"); }
template <int DV, int NMAP>
__device__ __forceinline__ void attn_unit(LAS unsigned char* lds, const bf16_t* U, bf16_t* MIX, const float* logf, int b, int h, int qb, float lam, float slope2, const float* gn, float outscale, const int tid) {
    constexpr int QROWS = NMAP == 2 ? 128 : 256, NDB = DV / 32, NVR = DV / 64, PIECES = DV / 8, VT = NDB * 4096;
    constexpr int NST = 3, AT_V = AT_K + NST * NMAP * AT_KT, PER = NMAP + NVR;
    const int lane = tid & 63, wid = __builtin_amdgcn_readfirstlane(tid >> 6), r32 = lane & 31, hi = lane >> 5;
    const int map = NMAP == 2 ? (wid >> 2) : 0;
    const int q0 = qb * QROWS, qrow0 = q0 + 32 * (NMAP == 2 ? (wid & 3) : wid);
    const size_t rowbase = (size_t)b * SEQ;
    const int NT = (q0 + QROWS) / 64;
    const int qcol = NMAP == 2 ? 1536 + 128 * h : 64 * h, kcol = NMAP == 2 ? 2048 + 128 * h : 512 + 64 * h, vcol = NMAP == 2 ? 2560 + 128 * h : 1024 + 64 * h;
    LAS float* bias = (LAS float*)(lds + AT_BIAS);
    {
        const int n = q0 + QROWS;
        if (NMAP == 1) {
            LAS float* scan = (LAS float*)(lds + AT_SCAN);
            LAS float* tots = (LAS float*)(lds + AT_K);
            float v0 = 0.f, v1 = 0.f, v2 = 0.f, v3 = 0.f;
            if (4 * tid < n) { const float* lp = logf + (rowbase + 4 * tid) * 8 + h; v0 = lp[0]; v1 = lp[8]; v2 = lp[16]; v3 = lp[24]; }
            const float p1 = v0, p2 = v0 + v1, p3 = p2 + v2, tot = p3 + v3;
            tots[tid] = tot;
            __syncthreads();
            float incl = 0.f, wsum = 0.f;
#pragma unroll
            for (int j4 = 0; j4 < 16; ++j4) { const f32x4 t = *(const LAS f32x4*)(tots + wid * 64 + 4 * j4);
#pragma unroll
                for (int i = 0; i < 4; ++i) { wsum += t[i]; incl += (4 * j4 + i <= lane) ? t[i] : 0.f; } }
            if (lane == 63) scan[wid] = wsum;
            __syncthreads();
            float wpre = 0.f;
            for (int w = 0; w < wid; ++w) wpre += scan[w];
            const float ex = wpre + incl - tot;
            if (4 * tid < n) *(LAS f32x4*)(bias + 4 * tid) = (f32x4){-(ex + p1) * LOG2E, -(ex + p2) * LOG2E, -(ex + p3) * LOG2E, -(ex + tot) * LOG2E};
        } else {
            for (int s = tid; s < n; s += 512) bias[s] = slope2 * (float)s;
        }
    }
    bf16x8 qr[4];
    {
        const bf16_t* qp = U + (rowbase + qrow0 + r32) * UW + qcol + map * 64 + hi * 8;
#pragma unroll
        for (int d0 = 0; d0 < 4; ++d0) qr[d0] = __builtin_nontemporal_load((const bf16x8*)(qp + 16 * d0));
    }
    asm volatile("" : "+v"(qr[0]), "+v"(qr[1]), "+v"(qr[2]), "+v"(qr[3]));
    const bf16_t* kg = U + (rowbase + lane) * UW + kcol + wid * 8;
    const bf16_t* vg = U + (rowbase + 16 * (wid & 3) + (lane >> 2)) * UW + vcol + (wid >> 2) * 32 + (lane & 3) * 8;
    const unsigned ldsb = (unsigned)(size_t)lds;
#define AT_DMA(t, stg) do { \
        _Pragma("unroll") for (int m_ = 0; m_ < NMAP; ++m_) glds16(kg + (size_t)(t) * 64 * UW + m_ * 64, (unsigned)__builtin_amdgcn_readfirstlane((int)(ldsb + AT_K + ((stg) * NMAP + m_) * AT_KT + wid * 1056))); \
        _Pragma("unroll") for (int i_ = 0; i_ < NVR; ++i_) glds16(vg + (size_t)(t) * 64 * UW + i_ * 64, (unsigned)__builtin_amdgcn_readfirstlane((int)(ldsb + AT_V + (stg) * VT + ((wid >> 2) + 2 * i_) * 4096 + (wid & 3) * 1024))); } while (0)
    __syncthreads();
    AT_DMA(0, 0);
    if (NT > 1) AT_DMA(1, 1);
    const float m_run = bias[qrow0 + r32];
    float l_run = 0.f;
    f32x16 o[NDB];
#pragma unroll
    for (int d = 0; d < NDB; ++d)
#pragma unroll
        for (int r = 0; r < 16; ++r) o[d][r] = 0.f;
    const int vofs = (4 * hi + ((lane & 15) >> 2)) * 64 + ((lane >> 4) & 1) * 32 + (lane & 3) * 8;
    int st = 0, st2 = 2;
    for (int t = 0; t < NT; ++t) {
        if (t + 1 < NT) { if (PER == 2) asm volatile("s_waitcnt vmcnt(2)\n\ts_barrier" ::: "memory"); else asm volatile("s_waitcnt vmcnt(4)\n\ts_barrier" ::: "memory"); }
        else asm volatile("s_waitcnt vmcnt(0)\n\ts_barrier" ::: "memory");
        if (t + 2 < NT) AT_DMA(t + 2, st2);
        if (64 * t <= qrow0 + 31) {
            const LAS unsigned char* Kb = lds + AT_K + (st * NMAP + map) * AT_KT + r32 * 16;
            const LAS unsigned char* Vb = lds + AT_V + st * VT + vofs;
            f32x16 p0, p1;
            {
                const LAS float* bp = bias + 64 * t + 4 * hi;
#pragma unroll
                for (int g = 0; g < 4; ++g) { const f32x4 v = *(const LAS f32x4*)(bp + 8 * g), w = *(const LAS f32x4*)(bp + 32 + 8 * g);
                    p0[4 * g] = v[0]; p0[4 * g + 1] = v[1]; p0[4 * g + 2] = v[2]; p0[4 * g + 3] = v[3]; p1[4 * g] = w[0]; p1[4 * g + 1] = w[1]; p1[4 * g + 2] = w[2]; p1[4 * g + 3] = w[3]; }
            }
            {
                bf16x8 kf[8];
#pragma unroll
                for (int d0 = 0; d0 < 4; ++d0) { kf[2 * d0] = *(const LAS bf16x8*)(Kb + (2 * d0 + hi) * 1056); kf[2 * d0 + 1] = *(const LAS bf16x8*)(Kb + (2 * d0 + hi) * 1056 + 512); }
                __builtin_amdgcn_sched_barrier(0);
#pragma unroll
                for (int d0 = 0; d0 < 4; ++d0) {
                    p0 = __builtin_amdgcn_mfma_f32_32x32x16_bf16(kf[2 * d0], qr[d0], p0, 0, 0, 0);
                    p1 = __builtin_amdgcn_mfma_f32_32x32x16_bf16(kf[2 * d0 + 1], qr[d0], p1, 0, 0, 0);
                }
                __builtin_amdgcn_sched_barrier(0);
            }
            if (64 * t + 63 > qrow0) {
                const int q = qrow0 + r32, kv0 = 64 * t + 4 * hi;
#pragma unroll
                for (int r = 0; r < 16; ++r) { const int kv = kv0 + (r & 3) + 8 * (r >> 2); if (kv > q) p0[r] = -1e30f; if (kv + 32 > q) p1[r] = -1e30f; }
            }
            s16x4 lo[2][4], hh[2][4];
#pragma unroll
            for (int e = 0; e < 2; ++e)
#pragma unroll
                for (int s = 0; s < 4; ++s) { lo[e][s] = vtr(Vb + e * 4096 + s * 1024); hh[e][s] = vtr(Vb + e * 4096 + s * 1024 + 512); }
            __builtin_amdgcn_sched_barrier(0);
            {
                float s0 = 0.f, s1 = 0.f, s2 = 0.f, s3 = 0.f;
#pragma unroll
                for (int r = 0; r < 16; r += 2) { p0[r] = __builtin_amdgcn_exp2f(p0[r] - m_run); p0[r + 1] = __builtin_amdgcn_exp2f(p0[r + 1] - m_run); p1[r] = __builtin_amdgcn_exp2f(p1[r] - m_run); p1[r + 1] = __builtin_amdgcn_exp2f(p1[r + 1] - m_run);
                    s0 += p0[r]; s1 += p0[r + 1]; s2 += p1[r]; s3 += p1[r + 1]; }
                l_run += (s0 + s1) + (s2 + s3);
            }
            bf16x8 pk[4];
            {
                u32x4 w;
                w.x = pk_bf16(p0[0], p0[1]); w.y = pk_bf16(p0[2], p0[3]); w.z = pk_bf16(p0[4], p0[5]); w.w = pk_bf16(p0[6], p0[7]); pk[0] = __builtin_bit_cast(bf16x8, w);
                w.x = pk_bf16(p0[8], p0[9]); w.y = pk_bf16(p0[10], p0[11]); w.z = pk_bf16(p0[12], p0[13]); w.w = pk_bf16(p0[14], p0[15]); pk[1] = __builtin_bit_cast(bf16x8, w);
                w.x = pk_bf16(p1[0], p1[1]); w.y = pk_bf16(p1[2], p1[3]); w.z = pk_bf16(p1[4], p1[5]); w.w = pk_bf16(p1[6], p1[7]); pk[2] = __builtin_bit_cast(bf16x8, w);
                w.x = pk_bf16(p1[8], p1[9]); w.y = pk_bf16(p1[10], p1[11]); w.z = pk_bf16(p1[12], p1[13]); w.w = pk_bf16(p1[14], p1[15]); pk[3] = __builtin_bit_cast(bf16x8, w);
            }
            __builtin_amdgcn_sched_barrier(0);
            if (NDB == 4) {
                s16x4 lo2[2][4], hh2[2][4];
#pragma unroll
                for (int e = 0; e < 2; ++e)
#pragma unroll
                    for (int s = 0; s < 4; ++s) { lo2[e][s] = vtr(Vb + (2 + e) * 4096 + s * 1024); hh2[e][s] = vtr(Vb + (2 + e) * 4096 + s * 1024 + 512); }
                __builtin_amdgcn_sched_barrier(0);
#pragma unroll
                for (int s = 0; s < 4; ++s)
#pragma unroll
                    for (int e = 0; e < 2; ++e) {
                        const bf16x8 vf = (bf16x8){lo[e][s][0], lo[e][s][1], lo[e][s][2], lo[e][s][3], hh[e][s][0], hh[e][s][1], hh[e][s][2], hh[e][s][3]};
                        o[e] = __builtin_amdgcn_mfma_f32_32x32x16_bf16(vf, pk[s], o[e], 0, 0, 0);
                    }
                __builtin_amdgcn_sched_barrier(0);
#pragma unroll
                for (int s = 0; s < 4; ++s)
#pragma unroll
                    for (int e = 0; e < 2; ++e) {
                        const bf16x8 vf = (bf16x8){lo2[e][s][0], lo2[e][s][1], lo2[e][s][2], lo2[e][s][3], hh2[e][s][0], hh2[e][s][1], hh2[e][s][2], hh2[e][s][3]};
                        o[NDB - 2 + e] = __builtin_amdgcn_mfma_f32_32x32x16_bf16(vf, pk[s], o[NDB - 2 + e], 0, 0, 0);
                    }
            } else {
#pragma unroll
                for (int s = 0; s < 4; ++s)
#pragma unroll
                    for (int e = 0; e < 2; ++e) {
                        const bf16x8 vf = (bf16x8){lo[e][s][0], lo[e][s][1], lo[e][s][2], lo[e][s][3], hh[e][s][0], hh[e][s][1], hh[e][s][2], hh[e][s][3]};
                        o[e] = __builtin_amdgcn_mfma_f32_32x32x16_bf16(vf, pk[s], o[e], 0, 0, 0);
                    }
            }
            __builtin_amdgcn_sched_barrier(0);
        }
        st = (st == 2) ? 0 : st + 1; st2 = (st2 == 2) ? 0 : st2 + 1;
    }
#undef AT_DMA
    __syncthreads();
    const float inv = 1.0f / (l_run + __shfl_xor(l_run, 32));
    const size_t orow = (rowbase + qrow0 + r32) * DM;
    if (NMAP == 1) {
#pragma unroll
        for (int d = 0; d < NDB; ++d)
#pragma unroll
            for (int g = 0; g < 4; ++g) { u32x2 w; w.x = pk_bf16(o[d][4 * g] * inv, o[d][4 * g + 1] * inv); w.y = pk_bf16(o[d][4 * g + 2] * inv, o[d][4 * g + 3] * inv);
                *(u32x2*)(MIX + orow + 64 * h + 32 * d + 8 * g + 4 * hi) = w; }
        __syncthreads();
    } else {
        LAS float* ex = (LAS float*)(lds + AT_K) + (size_t)(wid & 3) * 4096 + lane;
        if (map == 1) {
#pragma unroll
            for (int d = 0; d < NDB; ++d)
#pragma unroll
                for (int r = 0; r < 16; ++r) ex[(d * 16 + r) * 64] = lam * (o[d][r] * inv);
        }
        __syncthreads();
        if (map == 0) {
            float ss = 0.f;
#pragma unroll
            for (int d = 0; d < NDB; ++d)
#pragma unroll
                for (int r = 0; r < 16; ++r) { const float v = o[d][r] * inv - ex[(d * 16 + r) * 64]; o[d][r] = v; ss += v * v; }
            ss += __shfl_xor(ss, 32);
            const float rn = outscale / sqrtf(ss * (1.0f / 128.0f) + EPS);
#pragma unroll
            for (int d = 0; d < NDB; ++d)
#pragma unroll
                for (int g = 0; g < 4; ++g) { const f32x4 gv = *(const f32x4*)(gn + 32 * d + 8 * g + 4 * hi);
                    u32x2 w; w.x = pk_bf16(o[d][4 * g] * rn * gv[0], o[d][4 * g + 1] * rn * gv[1]); w.y = pk_bf16(o[d][4 * g + 2] * rn * gv[2], o[d][4 * g + 3] * rn * gv[3]);
                    *(u32x2*)(MIX + orow + 512 + 128 * h + 32 * d + 8 * g + 4 * hi) = w; }
        }
        __syncthreads();
    }
}

__device__ __forceinline__ void attn_phase(const Args& a, int l, LAS unsigned char* lds, const int tid, const int rep) {
    const int lane = tid & 63;
    unsigned char* ws = a.ws;
    const bf16_t* U = (const bf16_t*)(ws + WS_U); bf16_t* MIX = (bf16_t*)(ws + WS_MIX); const float* logf = (const float*)(ws + WS_LOGF);
    unsigned* ctr = (unsigned*)(ws + WS_CTR) + l + 2 * rep;
    int lop = l; asm volatile("" : "+s"(lop));
    const float lam_init = 0.8f - 0.6f * expf(-0.3f * (float)lop);
    float lam;
    {
        const float* lv = a.in[10] + l * 256;
        const float sa = wave_sum(lv[lane] * lv[64 + lane]), sb = wave_sum(lv[128 + lane] * lv[192 + lane]);
        lam = expf(sa) - expf(sb) + lam_init;
    }
    const float* gn = a.in[11] + l * 128;
    volatile LAS unsigned* nextu = (volatile LAS unsigned*)(lds + AT_NEXT);
    for (;;) {
        if (tid == 0) *nextu = atomicAdd(ctr, 1u);
        __syncthreads();
        const unsigned i = *nextu;
        __syncthreads();
        if (i >= 1024u) break;
        if (i < 512u) {
            const int qb = 15 - (int)(i >> 5), bh = (int)(i & 31), b = bh >> 2, h = bh & 3;
            const float slope2 = exp2f(-2.0f * (float)(h + 1)) * LOG2E;
            attn_unit<128, 2>(lds, U, MIX, logf, b, h, qb, lam, slope2, gn, 1.0f - lam_init, tid);
        } else {
            const int j = (int)i - 512, qb = 7 - (j >> 6), bh = j & 63, b = bh >> 3, h = bh & 7;
            attn_unit<64, 1>(lds, U, MIX, logf, b, h, qb, 0.f, 0.f, gn, 1.f, tid);
        }
    }
}

#define XB_TMO      128
#define XB_XCNT(j)  (256  + 64 * (j))
#define XB_XSUB(j)  (1280 + 64 * (j))
#define XB_XGEN(j)  (2304 + 64 * (j))
#define XB_TOP      3328
#define XB_TOPGEN   3392
#define XCD_BAR_WORDS 3456
#define XB_SPIN_CAP (1u << 18)

__device__ __forceinline__ unsigned xb_ld(unsigned* p)              { return __hip_atomic_load(p, __ATOMIC_RELAXED, __HIP_MEMORY_SCOPE_AGENT); }
__device__ __forceinline__ unsigned xb_add(unsigned* p, unsigned v) { return __hip_atomic_fetch_add(p, v, __ATOMIC_RELAXED, __HIP_MEMORY_SCOPE_AGENT); }
__device__ __forceinline__ unsigned xb_xcc_id() { return (unsigned)__builtin_amdgcn_s_getreg((3 << 11) | 20) & 0xFu; }
#define XB_SPIN(cond, bar) do { unsigned _sp = 0; while (cond) { __builtin_amdgcn_s_sleep(1); \
    if ((++_sp & 255u) == 0u) { if (xb_ld(&(bar)[XB_TMO])) break; if (_sp > XB_SPIN_CAP) { atomicAdd(&(bar)[XB_TMO], 1u); break; } } } } while (0)

struct XcdBarrier {
    unsigned* bar; unsigned x;
    volatile LAS unsigned* st;
};

__device__ __forceinline__ XcdBarrier xcd_barrier_post(unsigned* bar, volatile LAS unsigned* st, const int tid) {
    XcdBarrier b; b.bar = bar; b.x = xb_xcc_id(); b.st = st;
    if (tid == 0) (void)xb_add(&bar[XB_XCNT(b.x)], 1u);
    return b;
}
__device__ __forceinline__ void xcd_barrier_complete(unsigned* bar, unsigned x, unsigned& nloc, unsigned& nx) {
    const unsigned G = gridDim.x * gridDim.y * gridDim.z;
    unsigned sum, cnt, mine, sp = 0u;
    for (;;) {
        sum = 0u; cnt = 0u; mine = 0u;
#pragma nounroll
        for (unsigned j = 0; j < 16; ++j) { const unsigned c = xb_ld(&bar[XB_XCNT(j)]); sum += c; cnt += (c > 0u) ? 1u : 0u; mine = (j == x) ? c : mine; }
        if (sum == G) break;
        __builtin_amdgcn_s_sleep(1);
        if ((++sp & 255u) == 0u) { if (xb_ld(&bar[XB_TMO])) break; if (sp > XB_SPIN_CAP) { atomicAdd(&bar[XB_TMO], 1u); break; } }
    }
    nloc = mine > 0u ? mine : 1u; nx = cnt > 0u ? cnt : 1u;
}

__device__ __forceinline__ void xcd_barrier(const XcdBarrier& b, const int tid) {
    asm volatile("s_waitcnt vmcnt(0)" ::: "memory");
    __syncthreads();
    if (tid == 0) {
        unsigned* bar = b.bar;
        __builtin_amdgcn_s_waitcnt(0);
        unsigned nloc = b.st[0], nx = b.st[1];
        if (nloc == 0u) { xcd_barrier_complete(bar, b.x, nloc, nx); b.st[0] = nloc; b.st[1] = nx; }
        const unsigned old = xb_add(&bar[XB_XSUB(b.x)], 1u);
        const unsigned gen = old / nloc;
        if (old + 1u == (gen + 1u) * nloc) {
            __builtin_amdgcn_fence(__ATOMIC_RELEASE, "agent");
            asm volatile("s_waitcnt vmcnt(0)" ::: "memory");
            const unsigned og = xb_add(&bar[XB_TOP], 1u);
            const unsigned tg = og / nx;
            if (og + 1u == (tg + 1u) * nx) xb_add(&bar[XB_TOPGEN], 1u);
            else XB_SPIN(xb_ld(&bar[XB_TOPGEN]) == tg, bar);
            __builtin_amdgcn_fence(__ATOMIC_ACQUIRE, "agent");
            xb_add(&bar[XB_XGEN(b.x)], 1u);
            asm volatile("s_waitcnt vmcnt(0)" ::: "memory");
        } else {
            XB_SPIN(xb_ld(&bar[XB_XGEN(b.x)]) == gen, bar);
            __builtin_amdgcn_fence(__ATOMIC_ACQUIRE, "agent");
            asm volatile("s_waitcnt vmcnt(0)" ::: "memory");
        }
    }
    __syncthreads();
}

#ifndef PROBE_DUP
#define PROBE_DUP 0
#endif
#ifndef PH_MASK
#define PH_MASK 255
#endif
__global__ void __launch_bounds__(512, 2) fwd_kernel(Args a) {
    extern __shared__ __attribute__((aligned(16))) unsigned char lds_raw[];
    LAS unsigned char* lds = (LAS unsigned char*)lds_raw;
    cg::grid_group grid = cg::this_grid();
    volatile LAS unsigned* bst = (volatile LAS unsigned*)(lds + LDS_BYTES - 64);
    const int wid_s = __builtin_amdgcn_readfirstlane((int)threadIdx.x >> 6);
    if (threadIdx.x < 2) bst[threadIdx.x] = 0u;
    __syncthreads();
    XcdBarrier xbar = xcd_barrier_post((unsigned*)(a.ws + WS_CTR + 4096), bst, (int)threadIdx.x);
    unsigned char* ws = a.ws;
    bf16_t* H = (bf16_t*)(ws + WS_H); bf16_t* U = (bf16_t*)(ws + WS_U); bf16_t* ABUF = (bf16_t*)(ws + WS_U);
    const float* mod = (const float*)(ws + WS_MOD); float* logf = (float*)(ws + WS_LOGF);
    for (int ph = a.ph_lo; ph < a.ph_hi; ++ph) {
        const int nrep = 1 + ((a.probe >> (ph < 2 ? 6 + ph : (ph - 2) % 5)) & 1);
#pragma nounroll
        for (int rep = 0; rep < nrep; ++rep) {
        int tidv = (wid_s << 6) | (int)__builtin_amdgcn_mbcnt_hi(~0u, __builtin_amdgcn_mbcnt_lo(~0u, 0u)); asm volatile("" : "+v"(tidv));
        if (rep == 1) __syncthreads();
        if (ph == 0) prep_phase(a, lds, tidv);
        else if (ph == 1) norm0_phase(a, lds, tidv);
        else {
            const int l = (ph - 2) / 5, s = (ph - 2) % 5;
            const float* modl = mod + (size_t)l * 8 * MODW;
            float* rowss = (float*)(ws + WS_ROWSS); const float* gs = (const float*)(ws + WS_GS);
            if (s == 0) { pg8::Gemm g{H, (const bf16_t*)(ws + WS_WIN) + (size_t)l * UW * 1024, MT, UW, 1024}; pg8::StaticOrder S; S.init(MT, UW, (int)gridDim.x, (int)blockIdx.x);
                pg8::EpiIn E{U, a.in[8] + l * 128, a.in[9] + l * 128, pg8::Prefetch{S, rowss + (size_t)(2 * l) * MT * 4, (const float*)(ws + WS_SHW1) + (size_t)l * 8 * UW, UW, lds + PF_OFF}, 0};
                E.P.issue(0, (tidv >> 6) == 0, tidv & 63); pg8::gemm_phase<pg8::EpiIn, pg8::StaticOrder, true, true>(lds, g, S, E, tidv);
                fg_tail(a, l, lds, tidv); if (a.probe & 1024) fg_tail(a, l, lds, tidv); }
            else if (s == 1) attn_phase(a, l, lds, tidv, rep);
            else if (s == 2) { pg8::Gemm g{(const bf16_t*)(ws + WS_MIX), (const bf16_t*)(ws + WS_WOUT) + (size_t)l * 1024 * 1024, MT, 1024, 1024}; pg8::StaticOrder S; S.init(MT, 1024, (int)gridDim.x, (int)blockIdx.x);
                bf16_t* XB = (bf16_t*)(ws + WS_XB); pg8::EpiRes E{l == 0 ? a.in[0] : nullptr, l == 0 ? nullptr : XB, nullptr, XB, modl + 2048, H, gs + (size_t)(2 * l + 1) * 8 * 1024, rowss + (size_t)(2 * l + 1) * MT * 4, (LAS float*)(lds + RED_OFF)}; pg8::gemm_phase<pg8::EpiRes, pg8::StaticOrder, true, true>(lds, g, S, E, tidv); }
            else if (s == 3) { pg8::Gemm g{H, (const bf16_t*)(ws + WS_WGU) + (size_t)l * 2 * FF * 1024, MT, 2 * FF, 1024}; pg8::StaticOrder S; S.init(MT, 2 * FF, (int)gridDim.x, (int)blockIdx.x);
                pg8::EpiGU E{ABUF, pg8::Prefetch{S, rowss + (size_t)(2 * l + 1) * MT * 4, (const float*)(ws + WS_SHW2) + (size_t)l * 8 * 2 * FF, 2 * FF, lds + PF_OFF}, 0};
                E.P.issue(0, (tidv >> 6) == 0, tidv & 63); pg8::gemm_phase<pg8::EpiGU, pg8::StaticOrder, true, true>(lds, g, S, E, tidv);
                if (l == 0) {
                    const int rem = S.nwg % S.G, nidle = rem == 0 ? S.G : S.G - rem, me = rem == 0 ? S.c : S.c - rem;
                    if (me >= 0) { int tv3 = tidv; asm volatile("" : "+v"(tv3)); shw_tables(a, 2, 4, me * 8 + (tv3 >> 6), nidle * 8, tv3 & 63); weight_items(a, lds, tv3, 1); }
                } }
            else { const bool nxt = l + 1 < DEPTH; pg8::Gemm g{ABUF, (const bf16_t*)(ws + WS_WD) + (size_t)l * 1024 * FF, MT, 1024, FF}; pg8::StaticOrder S; S.init(MT, 1024, (int)gridDim.x, (int)blockIdx.x);
                bf16_t* XB = (bf16_t*)(ws + WS_XB); pg8::EpiRes E{nullptr, XB, nxt ? nullptr : a.out, nxt ? XB : nullptr, modl + 5120, nxt ? H : nullptr, gs + (size_t)(2 * l + 2) * 8 * 1024, rowss + (size_t)(2 * l + 2) * MT * 4, (LAS float*)(lds + RED_OFF)}; pg8::gemm_phase<pg8::EpiRes, pg8::StaticOrder, true, true>(lds, g, S, E, tidv); }
        }
        }
        if (ph + 1 < a.ph_hi) { const int tb = (wid_s << 6) | (int)__builtin_amdgcn_mbcnt_hi(~0u, __builtin_amdgcn_mbcnt_lo(~0u, 0u)); if (a.probe & 512) grid.sync(); else xcd_barrier(xbar, tb); if (a.probe & 256) xcd_barrier(xbar, tb); }
    }
}

#ifndef MK_ONE_LAUNCH
#define MK_ONE_LAUNCH 1
#endif
extern "C" void kernel_launch(void* const* d_in, const int* in_sizes, int n_in, void* d_out, int out_size, void* d_ws, size_t ws_size, hipStream_t stream) {
    static int grid = 0;
    if (grid == 0) {
        if (n_in != 16 || out_size != MT * DM || ws_size < WS_END) { fprintf(stderr, "kernel_launch: unexpected shapes (n_in %d out %d ws %zu)\n", n_in, out_size, ws_size); grid = -1; return; }
        int dev = 0, cus = 0, per_cu = 0;
        (void)hipGetDevice(&dev);
        (void)hipDeviceGetAttribute(&cus, hipDeviceAttributeMultiprocessorCount, dev);
        if (hipFuncSetAttribute((const void*)fwd_kernel, hipFuncAttributeMaxDynamicSharedMemorySize, LDS_BYTES) != hipSuccess) { fprintf(stderr, "kernel_launch: hipFuncSetAttribute failed\n"); grid = -1; return; }
        if (hipOccupancyMaxActiveBlocksPerMultiprocessor(&per_cu, (const void*)fwd_kernel, 512, LDS_BYTES) != hipSuccess || per_cu < 1) { fprintf(stderr, "kernel_launch: occupancy query gave %d\n", per_cu); per_cu = 1; }
        (void)hipGetLastError();
        grid = cus * (per_cu > 1 ? 1 : per_cu);
        if (grid <= 0) grid = 256;
    }
    if (grid < 0) return;
    Args a{};
    for (int i = 0; i < 16; ++i) a.in[i] = (const float*)d_in[i];
    a.out = (float*)d_out; a.ws = (unsigned char*)d_ws; a.probe = PROBE_DUP;
    (void)hipMemsetAsync((char*)d_ws + WS_CTR, 0, CTL_ZERO_BYTES, stream);
#if MK_ONE_LAUNCH
    a.ph_lo = 0; a.ph_hi = NPHASE;
    void* args[] = {&a};
    hipError_t e = hipLaunchCooperativeKernel((const void*)fwd_kernel, dim3(grid), dim3(512), args, LDS_BYTES, stream);
    if (e != hipSuccess) fprintf(stderr, "cooperative launch failed: %s (grid %d)\n", hipGetErrorString(e), grid);
#else
    for (int ph = 0; ph < NPHASE; ++ph) { a.ph_lo = ph; a.ph_hi = ph + 1; hipLaunchKernelGGL(fwd_kernel, dim3(grid), dim3(512), LDS_BYTES, stream, a); }
#endif
}
```

```cpp
#include <hip/hip_runtime.h>
#include <hip/hip_cooperative_groups.h>
#include <cstdio>
#include <cstdint>
namespace cg = cooperative_groups;
namespace pg8 {
#define PG8_LAS __attribute__((address_space(3)))
typedef unsigned short bf16_t;
typedef short bf16x8 __attribute__((ext_vector_type(8)));
typedef float f32x4 __attribute__((ext_vector_type(4)));
typedef unsigned u32x4 __attribute__((ext_vector_type(4)));
constexpr int BM = 256, BK = 64, HALF = 128, HTB = HALF * BK * 2  , STAGE_BYTES = 8 * HTB, NXCD = 8, WGM = 4;

__host__ __device__ __forceinline__ int lds_byte(int r, int c) { const int st = (r >> 4) * 2 + (c >> 5), rr = r & 15, cc = c & 31, ob = rr * 64 + cc * 2; return st * 1024 + (ob ^ (((ob >> 9) & 1) << 5)); }
__host__ __device__ __forceinline__ void stage_rc(int b, int& R, int& C) { const int st = b / 1024, sb = b % 1024, swz = sb ^ (((sb >> 9) & 1) << 5); R = (st >> 1) * 16 + swz / 64; C = (st & 1) * 32 + (swz % 64) / 2; }
__host__ __device__ __forceinline__ int perm32(int rho) { const int n = rho >> 4, i = rho & 15; return 8 * (i >> 2) + 4 * n + (i & 3); }

struct Unit { int pm, pn; };
struct Gemm { const bf16_t* A; const bf16_t* Bt; int M, N, K; };

struct StaticOrder {
    int nM, nN, nwg, G, c;
    __host__ __device__ void init(int M, int N, int G_, int c_) { nM = M / BM; nN = N / BM; nwg = nM * nN; G = G_; c = c_; }
    __host__ __device__ bool next(int i, Unit& u) const {
        const long L = (long)i * G + c; if (L >= nwg) return false;
        int wgid = (int)L; { const int q = nwg / NXCD, r = nwg % NXCD, xcd = wgid % NXCD, off = wgid / NXCD; wgid = (xcd < r ? xcd * (q + 1) : r * (q + 1) + (xcd - r) * q) + off; }
        const int nig = WGM * nN, gid = wgid / nig, fm = gid * WGM, gsz = (nM - fm) < WGM ? (nM - fm) : WGM;
        u.pm = fm + ((wgid % nig) % gsz); u.pn = (wgid % nig) / gsz; return true;
    }
    __device__ __forceinline__ void a_ready(const Unit&) const {}
    __device__ __forceinline__ void done(const Unit&) const {}
};

__device__ __forceinline__ unsigned cvt_pk_bf16(float lo, float hi) { unsigned r; asm volatile("v_cvt_pk_bf16_f32 %0, %1, %2" : "=v"(r) : "v"(lo), "v"(hi)); return r; }
constexpr float kLog2e = 1.4426950408889634f;
struct Prefetch {
    StaticOrder S; const float* rowss; const float* bias; int bstride; PG8_LAS unsigned char* pf;
    __device__ __forceinline__ void issue(int k, bool wave0, int lane) const {
        Unit u;
        if (wave0 && S.next(k, u)) {
            PG8_LAS unsigned char* slot = pf + (k & 1) * 5120;
#pragma unroll
            for (int q = 0; q < 4; ++q) __builtin_amdgcn_global_load_lds((const unsigned*)(rowss + (size_t)(u.pm * BM + 64 * q) * 4 + 4 * lane), (PG8_LAS unsigned*)(slot + 1024 * q), 16, 0, 0);
            __builtin_amdgcn_global_load_lds((const unsigned*)(bias + (u.pm >> 3) * bstride + u.pn * BM + 4 * lane), (PG8_LAS unsigned*)(slot + 4096), 16, 0, 0);
        }
    }
};
struct EpiIn {
    static constexpr bool PERM = true, AFTER_DRAIN = false; static constexpr int EXTRA_DMA = 5;
    bf16_t* U; const float* fox_g; const float* diff_g; Prefetch P; mutable int k;
    __device__ __forceinline__ void operator()(const f32x4 (&acc)[2][2][4][2], const Unit& u, int wr, int wc, int fr, int fq) const {
        const int seg = u.pn >> 1;
        const bool donorm = (seg != 2) && (seg != 5);
        const float* g = (seg < 3) ? fox_g + (seg == 1 ? 64 : 0) : diff_g + (seg == 4 ? 64 : 0);
        const float qs = (seg == 0 || seg == 3) ? 0.125f * kLog2e : 1.f;
        f32x4 gv[2][2], bv[2][2];
        P.issue(k + 1, wr == 0 && wc == 0, fr + 16 * fq);
        PG8_LAS const float* slot = (PG8_LAS const float*)(P.pf + (k & 1) * 5120); ++k;
        PG8_LAS const float* bp = slot + 1024 + 32 * wc + 8 * fq;
#pragma unroll
        for (int bj = 0; bj < 2; ++bj)
#pragma unroll
            for (int n = 0; n < 2; ++n) { gv[bj][n] = donorm ? (*(const f32x4*)(g + 32 * bj + 8 * fq + 4 * n)) * qs : (f32x4){1.f, 1.f, 1.f, 1.f}; bv[bj][n] = *(PG8_LAS const f32x4*)(bp + 128 * bj + 4 * n); }
        const int row0 = u.pm * BM + wr * 64 + fr, col0 = u.pn * BM + 64 * wc + 8 * fq;
        float rr[2][4];
#pragma unroll
        for (int ai = 0; ai < 2; ++ai)
#pragma unroll
            for (int m = 0; m < 4; ++m) { const f32x4 t = *(PG8_LAS const f32x4*)(slot + 4 * (wr * 64 + fr + ai * HALF + m * 16)); rr[ai][m] = (t[0] + t[1]) + (t[2] + t[3]); }
#pragma unroll
        for (int ai = 0; ai < 2; ++ai)
#pragma unroll
            for (int m = 0; m < 4; ++m) {
                const int row = row0 + ai * HALF + m * 16;
                const float r = __builtin_amdgcn_rsqf(rr[ai][m] * (1.0f / 1024.0f) + 1e-6f);
                f32x4 v[2][2];
#pragma unroll
                for (int bj = 0; bj < 2; ++bj)
#pragma unroll
                    for (int n = 0; n < 2; ++n) v[bj][n] = acc[ai][bj][m][n] * r + bv[bj][n];
                float sc = 1.f;
                if (donorm) {
                    float ss = 0.f;
#pragma unroll
                    for (int bj = 0; bj < 2; ++bj)
#pragma unroll
                        for (int n = 0; n < 2; ++n) { const f32x4 t = v[bj][n]; ss += (t[0] * t[0] + t[1] * t[1]) + (t[2] * t[2] + t[3] * t[3]); }
                    ss += __shfl_xor(ss, 16); ss += __shfl_xor(ss, 32);
                    sc = 1.0f / sqrtf(ss * (1.0f / 64.0f) + 1e-6f);
                }
                bf16_t* rowp = U + (size_t)row * 3072 + col0;
#pragma unroll
                for (int bj = 0; bj < 2; ++bj) {
                    const f32x4 v0 = v[bj][0] * gv[bj][0] * sc, v1 = v[bj][1] * gv[bj][1] * sc;
                    u32x4 w; w.x = cvt_pk_bf16(v0[0], v0[1]); w.y = cvt_pk_bf16(v0[2], v0[3]); w.z = cvt_pk_bf16(v1[0], v1[1]); w.w = cvt_pk_bf16(v1[2], v1[3]);
                    *(u32x4*)(rowp + 32 * bj) = w;
                }
            }
    }
};
struct EpiRes {
    static constexpr bool PERM = true, AFTER_DRAIN = false; static constexpr int EXTRA_DMA = 0;
    const float* xin32; const bf16_t* xin16; float* xout32; bf16_t* xout16; const float* gate; bf16_t* An; const float* gs; float* rowss_n; PG8_LAS float* red;
    template <bool IN16>
    __device__ __forceinline__ void rows(const f32x4 (&acc)[2][2][4][2], const Unit& u, int wr, int wc, int fr, int fq) const {
        const int b = u.pm >> 3, col0 = u.pn * BM + wc * 32 + 8 * fq, row0 = u.pm * BM + wr * 64 + fr;
        const bool nxt = An != nullptr, out16 = xout16 != nullptr;
        f32x4 gv[2][2], sv[2][2];
#pragma unroll
        for (int bj = 0; bj < 2; ++bj)
#pragma unroll
            for (int n = 0; n < 2; ++n) { gv[bj][n] = *(const f32x4*)(gate + b * 6144 + col0 + bj * HALF + n * 4); sv[bj][n] = nxt ? *(const f32x4*)(gs + b * 1024 + col0 + bj * HALF + n * 4) : (f32x4){0.f, 0.f, 0.f, 0.f}; }
#pragma unroll
        for (int ai = 0; ai < 2; ++ai)
#pragma unroll
            for (int m = 0; m < 4; ++m) { const int row = row0 + ai * HALF + m * 16; const size_t off = (size_t)row * 1024 + col0; float ss = 0.f;
#pragma unroll
                for (int bj = 0; bj < 2; ++bj) {
                    f32x4 xa, xb;
                    if (IN16) { const u32x4 w = __builtin_nontemporal_load((const u32x4*)(xin16 + off + bj * HALF));
                        xa = (f32x4){__builtin_bit_cast(float, w.x << 16), __builtin_bit_cast(float, w.x & 0xffff0000u), __builtin_bit_cast(float, w.y << 16), __builtin_bit_cast(float, w.y & 0xffff0000u)};
                        xb = (f32x4){__builtin_bit_cast(float, w.z << 16), __builtin_bit_cast(float, w.z & 0xffff0000u), __builtin_bit_cast(float, w.w << 16), __builtin_bit_cast(float, w.w & 0xffff0000u)}; }
                    else { xa = __builtin_nontemporal_load((const f32x4*)(xin32 + off + bj * HALF)); xb = __builtin_nontemporal_load((const f32x4*)(xin32 + off + bj * HALF + 4)); }
                    const f32x4 x0 = xa + gv[bj][0] * acc[ai][bj][m][0], x1 = xb + gv[bj][1] * acc[ai][bj][m][1];
                    if (out16) { u32x4 w; w.x = cvt_pk_bf16(x0[0], x0[1]); w.y = cvt_pk_bf16(x0[2], x0[3]); w.z = cvt_pk_bf16(x1[0], x1[1]); w.w = cvt_pk_bf16(x1[2], x1[3]); *(u32x4*)(xout16 + off + bj * HALF) = w; }
                    else { __builtin_nontemporal_store(x0, (f32x4*)(xout32 + off + bj * HALF)); __builtin_nontemporal_store(x1, (f32x4*)(xout32 + off + bj * HALF + 4)); }
                    if (nxt) { const f32x4 t0 = x0 * sv[bj][0], t1 = x1 * sv[bj][1];
                        u32x4 w; w.x = cvt_pk_bf16(t0[0], t0[1]); w.y = cvt_pk_bf16(t0[2], t0[3]); w.z = cvt_pk_bf16(t1[0], t1[1]); w.w = cvt_pk_bf16(t1[2], t1[3]);
                        *(u32x4*)(An + off + bj * HALF) = w;
                        ss += ((x0[0] * x0[0] + x0[1] * x0[1]) + (x0[2] * x0[2] + x0[3] * x0[3])) + ((x1[0] * x1[0] + x1[1] * x1[1]) + (x1[2] * x1[2] + x1[3] * x1[3])); } }
                if (nxt) { ss += __shfl_xor(ss, 16); ss += __shfl_xor(ss, 32); if (fq == 0) red[wc * 256 + wr * 64 + ai * HALF + m * 16 + fr] = ss; }
                if (!IN16 && m == 3) asm volatile("" ::: "memory"); }
    }
    __device__ __forceinline__ void operator()(const f32x4 (&acc)[2][2][4][2], const Unit& u, int wr, int wc, int fr, int fq) const {
        if (xin16 != nullptr) rows<true>(acc, u, wr, wc, fr, fq); else rows<false>(acc, u, wr, wc, fr, fq);
        if (An != nullptr) {
            asm volatile("s_waitcnt lgkmcnt(0)\n\ts_barrier" ::: "memory");
            const int t = (wr * 4 + wc) * 64 + fq * 16 + fr;
            if (t < 256) rowss_n[(size_t)(u.pm * BM + t) * 4 + u.pn] = (red[t] + red[256 + t]) + (red[512 + t] + red[768 + t]);
            asm volatile("s_waitcnt lgkmcnt(0)\n\ts_barrier" ::: "memory");
        }
    }
};
struct EpiGU {
    static constexpr bool PERM = true, AFTER_DRAIN = false; static constexpr int EXTRA_DMA = 5;
    bf16_t* Aout; Prefetch P; mutable int k;
    __device__ __forceinline__ float silu(float x) const { return x * __builtin_amdgcn_rcpf(1.0f + __builtin_amdgcn_exp2f(-x * kLog2e)); }
    __device__ __forceinline__ void operator()(const f32x4 (&acc)[2][2][4][2], const Unit& u, int wr, int wc, int fr, int fq) const {
        const int row0 = u.pm * BM + wr * 64 + fr, col0 = u.pn * 128 + 32 * wc + 8 * fq;
        P.issue(k + 1, wr == 0 && wc == 0, fr + 16 * fq);
        PG8_LAS const float* slot = (PG8_LAS const float*)(P.pf + (k & 1) * 5120); ++k;
        PG8_LAS const float* bp = slot + 1024 + 32 * wc + 8 * fq;
        const f32x4 bg0 = *(PG8_LAS const f32x4*)(bp), bg1 = *(PG8_LAS const f32x4*)(bp + 4), bu0 = *(PG8_LAS const f32x4*)(bp + 128), bu1 = *(PG8_LAS const f32x4*)(bp + 132);
        float rr[2][4];
#pragma unroll
        for (int ai = 0; ai < 2; ++ai)
#pragma unroll
            for (int m = 0; m < 4; ++m) { const f32x4 t = *(PG8_LAS const f32x4*)(slot + 4 * (wr * 64 + fr + ai * HALF + m * 16)); rr[ai][m] = (t[0] + t[1]) + (t[2] + t[3]); }
#pragma unroll
        for (int ai = 0; ai < 2; ++ai)
#pragma unroll
            for (int m = 0; m < 4; ++m) {
                const int row = row0 + ai * HALF + m * 16;
                const float r = __builtin_amdgcn_rsqf(rr[ai][m] * (1.0f / 1024.0f) + 1e-6f);
                const f32x4 g0 = acc[ai][0][m][0] * r + bg0, g1 = acc[ai][0][m][1] * r + bg1, u0 = acc[ai][1][m][0] * r + bu0, u1 = acc[ai][1][m][1] * r + bu1;
                u32x4 w; w.x = cvt_pk_bf16(silu(g0[0]) * u0[0], silu(g0[1]) * u0[1]); w.y = cvt_pk_bf16(silu(g0[2]) * u0[2], silu(g0[3]) * u0[3]);
                w.z = cvt_pk_bf16(silu(g1[0]) * u1[0], silu(g1[1]) * u1[1]); w.w = cvt_pk_bf16(silu(g1[2]) * u1[2], silu(g1[3]) * u1[3]);
                *(u32x4*)(Aout + (size_t)row * 2816 + col0) = w;
            }
    }
};

template <class Epi, class Sched, bool ALIGN_EPI = false, bool SP2 = false>
__device__ __forceinline__ void gemm_phase(PG8_LAS unsigned char* lds, const Gemm g, const Sched& S, const Epi& E, const int tid) {
    const int wid = __builtin_amdgcn_readfirstlane(tid >> 6), lane = tid & 63, wr = wid >> 2, wc = wid & 3, fr = lane & 15, fq = lane >> 4;
    const int K = g.K, nt = K / BK;
    unsigned voffA[2], voffB[2];
#pragma unroll
    for (int i = 0; i < 2; ++i) { int R, C; stage_rc(tid * 16 + i * 8192, R, C); const int Rb = Epi::PERM ? ((R & ~31) + perm32(R & 31)) : R;
        voffA[i] = (unsigned)(R * K + C) * 2u; voffB[i] = (unsigned)(Rb * K + C) * 2u; }
    const size_t kstep = (size_t)(BK * 2);
    const size_t hstep = (size_t)HALF * K * 2;
    const size_t tstep = 2 * hstep;
    const unsigned ldsw = (unsigned)wid * 1024u;
    const int aoff = lds_byte(wr * 64 + fr, fq * 8), boff = lds_byte(wc * 32 + fr, fq * 8);
#define PG8_SA(b, h) (((b) * 2 + (h)) * HTB)
#define PG8_SB(b, h) ((4 + (b) * 2 + (h)) * HTB)
#define PG8_STAGE(bufoff, gbase, voff) do { _Pragma("unroll") for (int _i = 0; _i < 2; ++_i) \
        __builtin_amdgcn_global_load_lds((const unsigned*)((const char*)(gbase) + (voff)[_i]), (PG8_LAS unsigned*)(lds + (bufoff) + ldsw + _i * 8192), 16, 0, 0); } while (0)
#define PG8_LDA(dst, b, h) do { _Pragma("unroll") for (int m = 0; m < 4; ++m) _Pragma("unroll") for (int k = 0; k < 2; ++k) dst[m][k] = *(const PG8_LAS bf16x8*)(lds + PG8_SA(b, h) + aoff + m * 2048 + k * 1024); } while (0)
#define PG8_LDB(dst, b, h) do { _Pragma("unroll") for (int n = 0; n < 2; ++n) _Pragma("unroll") for (int k = 0; k < 2; ++k) dst[n][k] = *(const PG8_LAS bf16x8*)(lds + PG8_SB(b, h) + boff + n * 2048 + k * 1024); } while (0)
#define PG8_MMA(ai, bj, At, Bt) do { __builtin_amdgcn_s_setprio(1); _Pragma("unroll") for (int m = 0; m < 4; ++m) _Pragma("unroll") for (int n = 0; n < 2; ++n) _Pragma("unroll") for (int k = 0; k < 2; ++k) \
        acc[ai][bj][m][n] = __builtin_amdgcn_mfma_f32_16x16x32_bf16(Bt[n][k], At[m][k], acc[ai][bj][m][n], 0, 0, 0); __builtin_amdgcn_s_setprio(0); } while (0)
#define PG8_WAIT_V(n) asm volatile("s_waitcnt vmcnt(" #n ")" ::: "memory")
#define PG8_WAIT_L(n) asm volatile("s_waitcnt lgkmcnt(" #n ")" ::: "memory")
#define PG8_BAR __builtin_amdgcn_s_barrier()
#define PG8_SCHED __builtin_amdgcn_sched_barrier(0)
    Unit cur, nxt; int ui = 0;
    if (!S.next(0, cur)) return;
    f32x4 acc[2][2][4][2];
#pragma unroll
    for (int a = 0; a < 2; ++a)
#pragma unroll
        for (int b = 0; b < 2; ++b)
#pragma unroll
            for (int m = 0; m < 4; ++m)
#pragma unroll
                for (int n = 0; n < 2; ++n) acc[a][b][m][n] = (f32x4){0.f, 0.f, 0.f, 0.f};
    bf16x8 At[4][2], B0[2][2], B1[2][2];
    const char* cA = (const char*)g.A + (size_t)cur.pm * tstep; const char* cB = (const char*)g.Bt + (size_t)cur.pn * tstep;
    S.a_ready(cur);
    if constexpr (SP2) {
        PG8_STAGE(PG8_SB(0, 0), cB, voffB); PG8_STAGE(PG8_SB(0, 1), cB + hstep, voffB); PG8_STAGE(PG8_SA(0, 0), cA, voffA); PG8_STAGE(PG8_SA(0, 1), cA + hstep, voffA);
        if (wr == 1) PG8_BAR;
        PG8_WAIT_V(2); PG8_BAR;
        PG8_STAGE(PG8_SB(1, 0), cB + kstep, voffB); PG8_STAGE(PG8_SA(1, 0), cA + kstep, voffA); PG8_STAGE(PG8_SB(1, 1), cB + hstep + kstep, voffB);
        PG8_WAIT_V(6); PG8_BAR;
    } else {
        PG8_STAGE(PG8_SB(0, 0), cB, voffB); PG8_STAGE(PG8_SA(0, 0), cA, voffA); PG8_STAGE(PG8_SB(0, 1), cB + hstep, voffB); PG8_STAGE(PG8_SA(0, 1), cA + hstep, voffA);
        if (wr == 1) PG8_BAR;
        PG8_WAIT_V(4); PG8_BAR;
        PG8_STAGE(PG8_SB(1, 0), cB + kstep, voffB); PG8_STAGE(PG8_SA(1, 0), cA + kstep, voffA); PG8_STAGE(PG8_SB(1, 1), cB + hstep + kstep, voffB);
        PG8_WAIT_V(6); PG8_BAR;
    }
    for (;;) {
        const bool has_next = S.next(ui + 1, nxt);
        const char* nA = has_next ? (const char*)g.A + (size_t)nxt.pm * tstep : cA; const char* nB = has_next ? (const char*)g.Bt + (size_t)nxt.pn * tstep : cB;
        for (int t = 0; t < nt; t += 2) {
            const bool last = (t == nt - 2);
            const char* a1 = cA + (size_t)(t + 1) * kstep;
            const char* a2 = last ? nA : cA + (size_t)(t + 2) * kstep; const char* b2 = last ? nB : cB + (size_t)(t + 2) * kstep;
            const char* a3 = a2 + kstep; const char* b3 = b2 + kstep;
            if (last && has_next) S.a_ready(nxt);
            if constexpr (SP2) {
            PG8_LDB(B0, 0, 0); PG8_LDB(B1, 0, 1); PG8_SCHED; PG8_LDA(At, 0, 0); PG8_STAGE(PG8_SA(1, 1), a1 + hstep, voffA);
            PG8_WAIT_V(8); PG8_WAIT_L(0); PG8_BAR; PG8_MMA(0, 0, At, B0); PG8_MMA(0, 1, At, B1); PG8_BAR; PG8_SCHED;
            PG8_LDA(At, 0, 1); PG8_STAGE(PG8_SB(0, 0), b2, voffB); PG8_STAGE(PG8_SB(0, 1), b2 + hstep, voffB); PG8_STAGE(PG8_SA(0, 0), a2, voffA);
            PG8_WAIT_V(8); PG8_WAIT_L(0); PG8_BAR; PG8_MMA(1, 0, At, B0); PG8_MMA(1, 1, At, B1); PG8_BAR; PG8_SCHED;
            PG8_LDB(B0, 1, 0); PG8_LDB(B1, 1, 1); PG8_SCHED; PG8_LDA(At, 1, 0); PG8_STAGE(PG8_SA(0, 1), a2 + hstep, voffA);
            PG8_WAIT_V(8); PG8_WAIT_L(0); PG8_BAR; PG8_MMA(0, 0, At, B0); PG8_MMA(0, 1, At, B1); PG8_BAR; PG8_SCHED;
            PG8_LDA(At, 1, 1); PG8_STAGE(PG8_SB(1, 0), b3, voffB); PG8_STAGE(PG8_SB(1, 1), b3 + hstep, voffB); PG8_STAGE(PG8_SA(1, 0), a3, voffA);
            PG8_WAIT_V(8); PG8_WAIT_L(0); PG8_BAR; PG8_MMA(1, 0, At, B0); PG8_MMA(1, 1, At, B1); PG8_BAR; PG8_SCHED;
            } else {
            PG8_LDB(B0, 0, 0); PG8_SCHED; PG8_LDA(At, 0, 0); PG8_STAGE(PG8_SA(1, 1), a1 + hstep, voffA);
            PG8_WAIT_L(8); PG8_BAR; PG8_WAIT_L(0); PG8_MMA(0, 0, At, B0); PG8_BAR; PG8_SCHED;
            PG8_LDB(B1, 0, 1); PG8_STAGE(PG8_SB(0, 0), b2, voffB);
            PG8_BAR; PG8_WAIT_L(0); PG8_MMA(0, 1, At, B1); PG8_BAR;
            PG8_LDA(At, 0, 1); PG8_STAGE(PG8_SA(0, 0), a2, voffA);
            PG8_BAR; PG8_WAIT_L(0); PG8_MMA(1, 0, At, B0); PG8_BAR; PG8_SCHED;
            PG8_STAGE(PG8_SB(0, 1), b2 + hstep, voffB);
            PG8_WAIT_V(6); PG8_BAR; PG8_MMA(1, 1, At, B1); PG8_BAR;
            PG8_LDB(B0, 1, 0); PG8_SCHED; PG8_LDA(At, 1, 0); PG8_STAGE(PG8_SA(0, 1), a2 + hstep, voffA);
            PG8_WAIT_L(8); PG8_BAR; PG8_WAIT_L(0); PG8_MMA(0, 0, At, B0); PG8_BAR; PG8_SCHED;
            PG8_LDB(B1, 1, 1); PG8_STAGE(PG8_SB(1, 0), b3, voffB);
            PG8_BAR; PG8_WAIT_L(0); PG8_MMA(0, 1, At, B1); PG8_BAR;
            PG8_LDA(At, 1, 1); PG8_STAGE(PG8_SA(1, 0), a3, voffA);
            PG8_BAR; PG8_WAIT_L(0); PG8_MMA(1, 0, At, B0); PG8_BAR; PG8_SCHED;
            PG8_STAGE(PG8_SB(1, 1), b3 + hstep, voffB);
            PG8_WAIT_V(6); PG8_BAR; PG8_MMA(1, 1, At, B1); PG8_BAR;
            }
        }
        if constexpr (ALIGN_EPI) { if (wr == 0) PG8_BAR; }
        if constexpr (!Epi::AFTER_DRAIN) { E(acc, cur, wr, wc, fr, fq); S.done(cur); }
        if (!has_next) break;
#pragma unroll
        for (int a = 0; a < 2; ++a)
#pragma unroll
            for (int b = 0; b < 2; ++b)
#pragma unroll
                for (int m = 0; m < 4; ++m)
#pragma unroll
                    for (int n = 0; n < 2; ++n) acc[a][b][m][n] = (f32x4){0.f, 0.f, 0.f, 0.f};
        cur = nxt; cA = nA; cB = nB; ++ui;
        if constexpr (ALIGN_EPI) { if (wr == 1) PG8_BAR; }
    }
    PG8_WAIT_V(0);
    if constexpr (!ALIGN_EPI) { if (wr == 0) PG8_BAR; }
    PG8_BAR;
    if constexpr (Epi::AFTER_DRAIN) { E.fused(acc, cur, wr, wc, fr, fq, lds, wid, lane); S.done(cur); }
#undef PG8_SA
#undef PG8_SB
#undef PG8_STAGE
#undef PG8_LDA
#undef PG8_LDB
#undef PG8_MMA
#undef PG8_WAIT_V
#undef PG8_WAIT_L
#undef PG8_BAR
#undef PG8_SCHED
}
}
#define LAS __attribute__((address_space(3)))
typedef unsigned short bf16_t;
typedef short bf16x8 __attribute__((ext_vector_type(8)));
typedef short s16x4 __attribute__((ext_vector_type(4)));
typedef float f32x4 __attribute__((ext_vector_type(4)));
typedef float f32x16 __attribute__((ext_vector_type(16)));
typedef unsigned u32x4 __attribute__((ext_vector_type(4)));
typedef unsigned u32x2 __attribute__((ext_vector_type(2)));

constexpr int NB = 8, SEQ = 2048, DM = 1024, MT = NB * SEQ, DEPTH = 2, INW = 3080, UW = 3072, FF = 2816, MODW = 6144;
constexpr float EPS = 1e-6f, LOG2E = 1.4426950408889634f;
constexpr size_t MiB = 1u << 20;
constexpr size_t WS_CTR = 0, WS_MOD = 1 * MiB, WS_LOGF = 2 * MiB, WS_WIN = 4 * MiB, WS_WOUT = 16 * MiB, WS_WGU = 20 * MiB, WS_WD = 42 * MiB, WS_H = 54 * MiB, WS_U = 86 * MiB, WS_MIX = 182 * MiB, WS_SHW1 = 216 * MiB, WS_SHW2 = 217 * MiB, WS_GS = 218 * MiB, WS_XB = 220 * MiB, WS_END = 252 * MiB;
constexpr size_t WS_ROWSS = 3 * MiB, CTL_ZERO_BYTES = 65536, WS_WFGT = 2 * MiB + 512 * 1024;
constexpr int LDS_BYTES = 131072 + 2 * 5120 + 4096 + 1024, PF_OFF = 131072, RED_OFF = 131072 + 2 * 5120;
constexpr int NPHASE = 2 + 5 * DEPTH;

struct Args { const float* in[16]; float* out; unsigned char* ws; int ph_lo, ph_hi, probe, pad; };

__device__ __forceinline__ float wave_sum(float v) {
#pragma unroll
    for (int o = 1; o < 64; o <<= 1) v += __shfl_xor(v, o);
    return v;
}
__device__ __forceinline__ unsigned pk_bf16(float lo, float hi) { return pg8::cvt_pk_bf16(lo, hi); }

__device__ __forceinline__ float reduce8(const float (&d)[8], int lane) {
    const bool h32 = (lane & 32) != 0, h16 = (lane & 16) != 0, h8 = (lane & 8) != 0;
    float e[4];
#pragma unroll
    for (int i = 0; i < 4; ++i) { const float snd = h32 ? d[i] : d[4 + i], kp = h32 ? d[4 + i] : d[i]; e[i] = kp + __shfl_xor(snd, 32); }
    float f[2];
#pragma unroll
    for (int i = 0; i < 2; ++i) { const float snd = h16 ? e[i] : e[2 + i], kp = h16 ? e[2 + i] : e[i]; f[i] = kp + __shfl_xor(snd, 16); }
    const float snd = h8 ? f[0] : f[1], kp = h8 ? f[1] : f[0];
    float g = kp + __shfl_xor(snd, 8);
    g += __shfl_xor(g, 4); g += __shfl_xor(g, 2); g += __shfl_xor(g, 1);
    return g;
}

__device__ __forceinline__ void weight_items(const Args& a, LAS unsigned char* lds, const int tid, const int sel) {
    unsigned char* ws = a.ws;
    {
        LAS float* tile = (LAS float*)lds;
        volatile LAS unsigned* nx = (volatile LAS unsigned*)(lds + 64 * 260 * 4);
        unsigned* qctr = (unsigned*)(ws + WS_CTR) + 8 + sel;
        constexpr int PER_L = 192 + 64 + 352 + 176; const int NIT = sel == 0 ? PER_L + 192 + 352 : 64 + 176;
        const int c4 = tid & 63, r0 = tid >> 6;
        f32x4 v[8];
        const float* src = nullptr; size_t ld = 0; bf16_t* dst = nullptr; int K = 0, k0 = 0, mode = 0;
#define PREP_DECODE(it_) do { int r = (int)(it_), l = 0; if (sel == 0) { if (r >= PER_L) { r -= PER_L; l = 1; if (r >= 192) r += 64; } } else { l = 1; r = r < 64 ? 192 + r : 608 + (r - 64); } int pn, kb; mode = 0; \
            if (r < 192) { pn = r % 12; kb = r / 12; src = a.in[6] + (size_t)l * 1024 * INW + 256 * pn + (pn >= 6 ? 8 : 0) + 4 * c4; ld = INW; K = 1024; mode = 1; dst = (bf16_t*)(ws + WS_WIN) + (size_t)l * UW * 1024 + (size_t)(256 * pn) * 1024; } \
            else if (r < 256) { r -= 192; pn = r % 4; kb = r / 4; src = a.in[12] + (size_t)l * 1024 * 1024 + 256 * pn + 4 * c4; ld = 1024; K = 1024; dst = (bf16_t*)(ws + WS_WOUT) + (size_t)l * 1024 * 1024 + (size_t)(256 * pn) * 1024; } \
            else if (r < 608) { r -= 256; pn = r % 22; kb = r / 22; src = ((c4 >> 5) ? a.in[14] : a.in[13]) + (size_t)l * 1024 * FF + 128 * pn + 4 * (c4 & 31); ld = FF; K = 1024; dst = (bf16_t*)(ws + WS_WGU) + (size_t)l * 2 * FF * 1024 + (size_t)(256 * pn) * 1024; } \
            else { r -= 608; pn = r % 4; kb = r / 4; src = a.in[15] + (size_t)l * FF * 1024 + 256 * pn + 4 * c4; ld = 1024; K = FF; dst = (bf16_t*)(ws + WS_WD) + (size_t)l * 1024 * FF + (size_t)(256 * pn) * FF; } \
            k0 = 64 * kb; } while (0)
#define PREP_LOAD() do { _Pragma("unroll") for (int i = 0; i < 8; ++i) v[i] = __builtin_nontemporal_load((const f32x4*)(src + (size_t)(k0 + r0 + 8 * i) * ld)); } while (0)
        if (tid == 0) *nx = atomicAdd(qctr, 1u);
        __syncthreads();
        unsigned it = *nx;
        if (it < (unsigned)NIT) { PREP_DECODE(it); PREP_LOAD(); }
        while (it < (unsigned)NIT) {
            __syncthreads();
            if (tid == 0) *nx = atomicAdd(qctr, 1u);
#pragma unroll
            for (int i = 0; i < 8; ++i) *(LAS f32x4*)(tile + (r0 + 8 * i) * 260 + 4 * c4) = v[i];
            bf16_t* cdst = dst; const int cK = K, ck0 = k0, cmode = mode;
            __syncthreads();
            const unsigned nit = *nx;
            if (nit < (unsigned)NIT) { PREP_DECODE(nit); PREP_LOAD(); }
            {
                const int p = tid & 255, half = tid >> 8;
                const int ns = cmode ? (64 * ((p >> 5) & 3) + 32 * (p >> 7) + (p & 31)) : p;
                const LAS float* sp = tile + (32 * half) * 260 + ns;
                bf16_t* dp = cdst + (size_t)p * cK + ck0 + 32 * half;
#pragma unroll
                for (int q = 0; q < 4; ++q) {
                    u32x4 o; o.x = pk_bf16(sp[(8 * q) * 260], sp[(8 * q + 1) * 260]); o.y = pk_bf16(sp[(8 * q + 2) * 260], sp[(8 * q + 3) * 260]);
                    o.z = pk_bf16(sp[(8 * q + 4) * 260], sp[(8 * q + 5) * 260]); o.w = pk_bf16(sp[(8 * q + 6) * 260], sp[(8 * q + 7) * 260]);
                    *(u32x4*)(dp + 8 * q) = o;
                }
            }
            it = nit;
        }
#undef PREP_DECODE
#undef PREP_LOAD
    }
    __syncthreads();
}

__device__ __forceinline__ void prep_phase(const Args& a, LAS unsigned char* lds, const int tid) {
    unsigned char* ws = a.ws;
    const int lane = tid & 63, wid = tid >> 6;
    if ((int)blockIdx.x < 96) {
        typedef float f32x2v __attribute__((ext_vector_type(2)));
        LAS float* condT = (LAS float*)lds;
        LAS float* red = (LAS float*)(lds + 32768);
        const int task = blockIdx.x, l = task / 48, cb = task % 48;
        for (int i = tid; i < 8192; i += 512) { const int b = i >> 10, k = i & 1023; const float v = a.in[1][b * 1024 + k]; condT[k * 8 + b] = v / (1.0f + __expf(-v)); }
        __syncthreads();
        const float* wp = a.in[4] + (size_t)l * 1024 * MODW + (size_t)(128 * wid) * MODW + 128 * cb + 2 * lane;
        f32x2v acc[8];
#pragma unroll
        for (int b = 0; b < 8; ++b) acc[b] = (f32x2v){0.f, 0.f};
#pragma unroll 32
        for (int k = 0; k < 128; ++k) {
            const f32x2v w = __builtin_nontemporal_load((const f32x2v*)(wp + (size_t)k * MODW));
            const f32x4 c0 = *(const LAS f32x4*)(condT + (128 * wid + k) * 8), c1 = *(const LAS f32x4*)(condT + (128 * wid + k) * 8 + 4);
            acc[0] += w * c0[0]; acc[1] += w * c0[1]; acc[2] += w * c0[2]; acc[3] += w * c0[3];
            acc[4] += w * c1[0]; acc[5] += w * c1[1]; acc[6] += w * c1[2]; acc[7] += w * c1[3];
        }
#pragma unroll
        for (int b = 0; b < 8; ++b) *(LAS f32x2v*)(red + (wid * 8 + b) * 128 + 2 * lane) = acc[b];
        __syncthreads();
#pragma unroll
        for (int j = 0; j < 2; ++j) {
            const int o = tid + 512 * j, b = o >> 7, c = o & 127; float sum = 0.f;
#pragma unroll
            for (int w = 0; w < 8; ++w) sum += red[(w * 8 + b) * 128 + c];
            ((float*)(ws + WS_MOD))[(size_t)(l * 8 + b) * MODW + 128 * cb + c] = sum + a.in[5][l * MODW + 128 * cb + c];
        }
        __syncthreads();
    }
    for (int idx = blockIdx.x * 512 + tid; idx < 2 * 8192; idx += gridDim.x * 512) {
        const int l = idx >> 13, k = (idx >> 3) & 1023, j = idx & 7;
        ((float*)(ws + WS_WFGT))[(size_t)l * 8192 + j * 1024 + k] = a.in[6][(size_t)l * 1024 * INW + (size_t)k * INW + 1536 + j];
    }
    weight_items(a, lds, tid, 0);
    __syncthreads();
}

__device__ __forceinline__ void shw_tables(const Args& a, int t_lo, int t_hi, int gw, int ngw, int lane) {
    unsigned char* ws = a.ws;
    const float* mod = (const float*)(ws + WS_MOD);
        for (int t = t_lo; t < t_hi; ++t) {
            const int l = t >> 1, type = t & 1, nrows = type ? 2 * FF : UW;
            const float* sh = mod + (size_t)l * 8 * MODW + (type ? 3072 : 0) + 16 * lane;
            const bf16_t* wbase = type ? (const bf16_t*)(ws + WS_WGU) + (size_t)l * 2 * FF * 1024 : (const bf16_t*)(ws + WS_WIN) + (size_t)l * UW * 1024;
            float* outp = type ? (float*)(ws + WS_SHW2) + (size_t)l * 8 * 2 * FF : (float*)(ws + WS_SHW1) + (size_t)l * 8 * UW;
            f32x4 sv[8][4];
#pragma unroll
            for (int b = 0; b < 8; ++b)
#pragma unroll
                for (int q = 0; q < 4; ++q) sv[b][q] = *(const f32x4*)(sh + (size_t)b * MODW + 4 * q);
            for (int r = gw; r < nrows; r += ngw) {
                const bf16_t* wrow = wbase + (size_t)r * 1024 + 16 * lane;
                const u32x4 w0 = *(const u32x4*)(wrow), w1 = *(const u32x4*)(wrow + 8);
                float wf[16];
#pragma unroll
                for (int i = 0; i < 4; ++i) { wf[2 * i] = __uint_as_float(w0[i] << 16); wf[2 * i + 1] = __uint_as_float(w0[i] & 0xffff0000u); wf[8 + 2 * i] = __uint_as_float(w1[i] << 16); wf[8 + 2 * i + 1] = __uint_as_float(w1[i] & 0xffff0000u); }
                float d8[8];
#pragma unroll
                for (int b = 0; b < 8; ++b) { float d = 0.f;
#pragma unroll
                    for (int q = 0; q < 4; ++q) d += (sv[b][q][0] * wf[4 * q] + sv[b][q][1] * wf[4 * q + 1]) + (sv[b][q][2] * wf[4 * q + 2] + sv[b][q][3] * wf[4 * q + 3]);
                    d8[b] = d; }
                const float tot = reduce8(d8, lane);
                if ((lane & 7) == 0) outp[(size_t)(lane >> 3) * nrows + r] = tot;
            }
        }
}

__device__ __forceinline__ void norm0_phase(const Args& a, LAS unsigned char* lds, const int tid) {
    const int lane = tid & 63, wid = tid >> 6;
    unsigned char* ws = a.ws;
    const float* mod = (const float*)(ws + WS_MOD);
    bf16_t* H = (bf16_t*)(ws + WS_H); float* rowss = (float*)(ws + WS_ROWSS);
    const int gw = blockIdx.x * 8 + wid, ngw = gridDim.x * 8;
    {
        const float* g = a.in[2];
        f32x4 gm[4];
#pragma unroll
        for (int j = 0; j < 4; ++j) gm[j] = *(const f32x4*)(g + 4 * lane + 256 * j);
        for (int chunk = gw; chunk * 8 < MT; chunk += ngw) {
            const int b = (chunk * 8) >> 11;
            f32x4 sc1[4];
#pragma unroll
            for (int j = 0; j < 4; ++j) sc1[j] = (*(const f32x4*)(mod + b * MODW + 1024 + 4 * lane + 256 * j) + 1.0f) * gm[j];
#pragma unroll 2
            for (int k = 0; k < 8; ++k) {
                const int row = chunk * 8 + k;
                const float* xr = a.in[0] + (size_t)row * DM + 4 * lane;
                f32x4 v[4]; float ss = 0.f;
#pragma unroll
                for (int j = 0; j < 4; ++j) { v[j] = __builtin_nontemporal_load((const f32x4*)(xr + 256 * j)); ss += (v[j][0] * v[j][0] + v[j][1] * v[j][1]) + (v[j][2] * v[j][2] + v[j][3] * v[j][3]); }
                ss = wave_sum(ss);
                if (lane == 0) *(f32x4*)(rowss + (size_t)row * 4) = (f32x4){ss, 0.f, 0.f, 0.f};
                bf16_t* hr = H + (size_t)row * DM + 4 * lane;
#pragma unroll
                for (int j = 0; j < 4; ++j) {
                    const f32x4 t = v[j] * sc1[j];
                    u32x2 o; o.x = pk_bf16(t[0], t[1]); o.y = pk_bf16(t[2], t[3]);
                    *(u32x2*)(hr + 256 * j) = o;
                }
            }
        }
    }
    {
        float* gs = (float*)(ws + WS_GS);
        for (int idx = blockIdx.x * 512 + tid; idx < 4 * 8 * 1024; idx += gridDim.x * 512) {
            const int inst = idx >> 13, b = (idx >> 10) & 7, col = idx & 1023, l = inst >> 1, which = inst & 1;
            const float g = (which ? a.in[3] : a.in[2])[l * DM + col], sc = mod[(size_t)(l * 8 + b) * MODW + (which ? 4096 : 1024) + col];
            gs[idx] = g * (1.0f + sc);
        }
    }
    shw_tables(a, 0, 2, gw, ngw, lane);
}
__device__ __forceinline__ void fg_tail(const Args& a, int l, LAS unsigned char* lds, const int tid) {
    const int lane = tid & 63, wid = tid >> 6;
    unsigned char* ws = a.ws;
    LAS f32x4* wl = (LAS f32x4*)lds;
    {
        const f32x4* wsrc = (const f32x4*)((const float*)(ws + WS_WFGT) + (size_t)l * 8192);
#pragma unroll
        for (int i = 0; i < 4; ++i) { const int idx = tid + 512 * i, j = idx >> 8, k4 = idx & 255, ln = k4 >> 2, q = k4 & 3; wl[(j * 4 + q) * 64 + ln] = wsrc[idx]; }
    }
    __syncthreads();
    const bf16_t* H = (const bf16_t*)(ws + WS_H); const float* rowss = (const float*)(ws + WS_ROWSS) + (size_t)(2 * l) * MT * 4;
    const float* mod = (const float*)(ws + WS_MOD) + (size_t)l * 8 * MODW; float* logf = (float*)(ws + WS_LOGF);
    const float bfv = a.in[7][l * 8 + (lane >> 3)];
    for (int chunk = blockIdx.x * 8 + wid; chunk * 8 < MT; chunk += gridDim.x * 8) {
        const int rowc = chunk * 8, b = rowc >> 11;
        f32x4 sh[4];
#pragma unroll
        for (int q = 0; q < 4; ++q) sh[q] = *(const f32x4*)(mod + (size_t)b * MODW + 16 * lane + 4 * q);
#pragma unroll 1
        for (int jb = 0; jb < 8; jb += 4) {
            f32x4 rs4v[4]; u32x4 w0v[4], w1v[4];
#pragma unroll
            for (int j = 0; j < 4; ++j) { const int row = rowc + jb + j; rs4v[j] = *(const f32x4*)(rowss + (size_t)row * 4); w0v[j] = *(const u32x4*)(H + (size_t)row * DM + 16 * lane); w1v[j] = *(const u32x4*)(H + (size_t)row * DM + 16 * lane + 8); }
#pragma unroll
            for (int j = 0; j < 4; ++j) {
                const int row = rowc + jb + j;
                const f32x4 rs4 = rs4v[j]; const u32x4 w0 = w0v[j], w1 = w1v[j];
                const float r = 1.0f / sqrtf(((rs4[0] + rs4[1]) + (rs4[2] + rs4[3])) * (1.0f / 1024.0f) + EPS);
                float h[16];
#pragma unroll
                for (int i = 0; i < 4; ++i) { h[2 * i] = __uint_as_float(w0[i] << 16); h[2 * i + 1] = __uint_as_float(w0[i] & 0xffff0000u); h[8 + 2 * i] = __uint_as_float(w1[i] << 16); h[8 + 2 * i + 1] = __uint_as_float(w1[i] & 0xffff0000u); }
#pragma unroll
                for (int q = 0; q < 4; ++q) { h[4 * q] = h[4 * q] * r + sh[q][0]; h[4 * q + 1] = h[4 * q + 1] * r + sh[q][1]; h[4 * q + 2] = h[4 * q + 2] * r + sh[q][2]; h[4 * q + 3] = h[4 * q + 3] * r + sh[q][3]; }
                float d8[8];
#pragma unroll
                for (int j8 = 0; j8 < 8; ++j8) { float acc = 0.f;
#pragma unroll
                    for (int q = 0; q < 4; ++q) { const f32x4 w = wl[(j8 * 4 + q) * 64 + lane]; acc += (h[4 * q] * w[0] + h[4 * q + 1] * w[1]) + (h[4 * q + 2] * w[2] + h[4 * q + 3] * w[3]); }
                    d8[j8] = acc; }
                const float tot = reduce8(d8, lane);
                if ((lane & 7) == 0) { const float z = tot + bfv; logf[(size_t)row * 8 + (lane >> 3)] = fminf(z, 0.f) - log1pf(__expf(-fabsf(z))); }
            }
        }
    }
    __syncthreads();
}

constexpr int AT_BIAS = 0, AT_SCAN = 8192, AT_NEXT = 8192 + 64, AT_K = 8448, AT_KT = 8 * 1056;
__device__ __forceinline__ s16x4 vtr(const LAS unsigned char* p) { typedef short v4i16_t __attribute__((ext_vector_type(4))); return __builtin_bit_cast(s16x4, __builtin_amdgcn_ds_read_tr16_b64_v4i16((LAS v4i16_t*)p)); }

__device__ __forceinline__ void glds16(const void* gsrc, unsigned lds_dst) { unsigned keep;
    asm volatile("s_mov_b32 %0, m0\n\ts_mov_b32 m0, %2\n\ts_nop 0\n\tglobal_load_lds_dwordx4 %1, off\n\ts_mov_b32 m0, %0" : "=&s"(keep) : "v"(gsrc), "s"(lds_dst) : "memory"); }
template <int DV, int NMAP>
__device__ __forceinline__ void attn_unit(LAS unsigned char* lds, const bf16_t* U, bf16_t* MIX, const float* logf, int b, int h, int qb, float lam, float slope2, const float* gn, float outscale, const int tid) {
    constexpr int QROWS = NMAP == 2 ? 128 : 256, NDB = DV / 32, NVR = DV / 64, PIECES = DV / 8, VT = NDB * 4096;
    constexpr int NST = 3, AT_V = AT_K + NST * NMAP * AT_KT, PER = NMAP + NVR;
    const int lane = tid & 63, wid = __builtin_amdgcn_readfirstlane(tid >> 6), r32 = lane & 31, hi = lane >> 5;
    const int map = NMAP == 2 ? (wid >> 2) : 0;
    const int q0 = qb * QROWS, qrow0 = q0 + 32 * (NMAP == 2 ? (wid & 3) : wid);
    const size_t rowbase = (size_t)b * SEQ;
    const int NT = (q0 + QROWS) / 64;
    const int qcol = NMAP == 2 ? 1536 + 128 * h : 64 * h, kcol = NMAP == 2 ? 2048 + 128 * h : 512 + 64 * h, vcol = NMAP == 2 ? 2560 + 128 * h : 1024 + 64 * h;
    LAS float* bias = (LAS float*)(lds + AT_BIAS);
    {
        const int n = q0 + QROWS;
        if (NMAP == 1) {
            LAS float* scan = (LAS float*)(lds + AT_SCAN);
            LAS float* tots = (LAS float*)(lds + AT_K);
            float v0 = 0.f, v1 = 0.f, v2 = 0.f, v3 = 0.f;
            if (4 * tid < n) { const float* lp = logf + (rowbase + 4 * tid) * 8 + h; v0 = lp[0]; v1 = lp[8]; v2 = lp[16]; v3 = lp[24]; }
            const float p1 = v0, p2 = v0 + v1, p3 = p2 + v2, tot = p3 + v3;
            tots[tid] = tot;
            __syncthreads();
            float incl = 0.f, wsum = 0.f;
#pragma unroll
            for (int j4 = 0; j4 < 16; ++j4) { const f32x4 t = *(const LAS f32x4*)(tots + wid * 64 + 4 * j4);
#pragma unroll
                for (int i = 0; i < 4; ++i) { wsum += t[i]; incl += (4 * j4 + i <= lane) ? t[i] : 0.f; } }
            if (lane == 63) scan[wid] = wsum;
            __syncthreads();
            float wpre = 0.f;
            for (int w = 0; w < wid; ++w) wpre += scan[w];
            const float ex = wpre + incl - tot;
            if (4 * tid < n) *(LAS f32x4*)(bias + 4 * tid) = (f32x4){-(ex + p1) * LOG2E, -(ex + p2) * LOG2E, -(ex + p3) * LOG2E, -(ex + tot) * LOG2E};
        } else {
            for (int s = tid; s < n; s += 512) bias[s] = slope2 * (float)s;
        }
    }
    bf16x8 qr[4];
    {
        const bf16_t* qp = U + (rowbase + qrow0 + r32) * UW + qcol + map * 64 + hi * 8;
#pragma unroll
        for (int d0 = 0; d0 < 4; ++d0) qr[d0] = *(const bf16x8*)(qp + 16 * d0);
    }
    asm volatile("" : "+v"(qr[0]), "+v"(qr[1]), "+v"(qr[2]), "+v"(qr[3]));
    const bf16_t* kg = U + (rowbase + lane) * UW + kcol + wid * 8;
    const bf16_t* vg = U + (rowbase + 16 * (wid & 3) + (lane >> 2)) * UW + vcol + (wid >> 2) * 32 + (lane & 3) * 8;
    const unsigned ldsb = (unsigned)(size_t)lds;
#define AT_DMA(t, stg) do { \
        _Pragma("unroll") for (int m_ = 0; m_ < NMAP; ++m_) glds16(kg + (size_t)(t) * 64 * UW + m_ * 64, (unsigned)__builtin_amdgcn_readfirstlane((int)(ldsb + AT_K + ((stg) * NMAP + m_) * AT_KT + wid * 1056))); \
        _Pragma("unroll") for (int i_ = 0; i_ < NVR; ++i_) glds16(vg + (size_t)(t) * 64 * UW + i_ * 64, (unsigned)__builtin_amdgcn_readfirstlane((int)(ldsb + AT_V + (stg) * VT + ((wid >> 2) + 2 * i_) * 4096 + (wid & 3) * 1024))); } while (0)
    __syncthreads();
    AT_DMA(0, 0);
    if (NT > 1) AT_DMA(1, 1);
    const float m_run = bias[qrow0 + r32];
    float l_run = 0.f;
    f32x16 o[NDB];
#pragma unroll
    for (int d = 0; d < NDB; ++d)
#pragma unroll
        for (int r = 0; r < 16; ++r) o[d][r] = 0.f;
    const int vofs = (4 * hi + ((lane & 15) >> 2)) * 64 + ((lane >> 4) & 1) * 32 + (lane & 3) * 8;
    int st = 0, st2 = 2;
    for (int t = 0; t < NT; ++t) {
        if (t + 1 < NT) { if (PER == 2) asm volatile("s_waitcnt vmcnt(2)\n\ts_barrier" ::: "memory"); else asm volatile("s_waitcnt vmcnt(4)\n\ts_barrier" ::: "memory"); }
        else asm volatile("s_waitcnt vmcnt(0)\n\ts_barrier" ::: "memory");
        if (t + 2 < NT) AT_DMA(t + 2, st2);
        if (64 * t <= qrow0 + 31) {
            const LAS unsigned char* Kb = lds + AT_K + (st * NMAP + map) * AT_KT + r32 * 16;
            const LAS unsigned char* Vb = lds + AT_V + st * VT + vofs;
            f32x16 p0, p1;
            {
                const LAS float* bp = bias + 64 * t + 4 * hi;
#pragma unroll
                for (int g = 0; g < 4; ++g) { const f32x4 v = *(const LAS f32x4*)(bp + 8 * g), w = *(const LAS f32x4*)(bp + 32 + 8 * g);
                    p0[4 * g] = v[0]; p0[4 * g + 1] = v[1]; p0[4 * g + 2] = v[2]; p0[4 * g + 3] = v[3]; p1[4 * g] = w[0]; p1[4 * g + 1] = w[1]; p1[4 * g + 2] = w[2]; p1[4 * g + 3] = w[3]; }
            }
            {
                bf16x8 kf[8];
#pragma unroll
                for (int d0 = 0; d0 < 4; ++d0) { kf[2 * d0] = *(const LAS bf16x8*)(Kb + (2 * d0 + hi) * 1056); kf[2 * d0 + 1] = *(const LAS bf16x8*)(Kb + (2 * d0 + hi) * 1056 + 512); }
                __builtin_amdgcn_sched_barrier(0);
#pragma unroll
                for (int d0 = 0; d0 < 4; ++d0) {
                    p0 = __builtin_amdgcn_mfma_f32_32x32x16_bf16(kf[2 * d0], qr[d0], p0, 0, 0, 0);
                    p1 = __builtin_amdgcn_mfma_f32_32x32x16_bf16(kf[2 * d0 + 1], qr[d0], p1, 0, 0, 0);
                }
                __builtin_amdgcn_sched_barrier(0);
            }
            if (64 * t + 63 > qrow0) {
                const int q = qrow0 + r32, kv0 = 64 * t + 4 * hi;
#pragma unroll
                for (int r = 0; r < 16; ++r) { const int kv = kv0 + (r & 3) + 8 * (r >> 2); if (kv > q) p0[r] = -1e30f; if (kv + 32 > q) p1[r] = -1e30f; }
            }
            s16x4 lo[2][4], hh[2][4];
#pragma unroll
            for (int e = 0; e < 2; ++e)
#pragma unroll
                for (int s = 0; s < 4; ++s) { lo[e][s] = vtr(Vb + e * 4096 + s * 1024); hh[e][s] = vtr(Vb + e * 4096 + s * 1024 + 512); }
            __builtin_amdgcn_sched_barrier(0);
            {
                float s0 = 0.f, s1 = 0.f, s2 = 0.f, s3 = 0.f;
#pragma unroll
                for (int r = 0; r < 16; r += 2) { p0[r] = __builtin_amdgcn_exp2f(p0[r] - m_run); p0[r + 1] = __builtin_amdgcn_exp2f(p0[r + 1] - m_run); p1[r] = __builtin_amdgcn_exp2f(p1[r] - m_run); p1[r + 1] = __builtin_amdgcn_exp2f(p1[r + 1] - m_run);
                    s0 += p0[r]; s1 += p0[r + 1]; s2 += p1[r]; s3 += p1[r + 1]; }
                l_run += (s0 + s1) + (s2 + s3);
            }
            bf16x8 pk[4];
            {
                u32x4 w;
                w.x = pk_bf16(p0[0], p0[1]); w.y = pk_bf16(p0[2], p0[3]); w.z = pk_bf16(p0[4], p0[5]); w.w = pk_bf16(p0[6], p0[7]); pk[0] = __builtin_bit_cast(bf16x8, w);
                w.x = pk_bf16(p0[8], p0[9]); w.y = pk_bf16(p0[10], p0[11]); w.z = pk_bf16(p0[12], p0[13]); w.w = pk_bf16(p0[14], p0[15]); pk[1] = __builtin_bit_cast(bf16x8, w);
                w.x = pk_bf16(p1[0], p1[1]); w.y = pk_bf16(p1[2], p1[3]); w.z = pk_bf16(p1[4], p1[5]); w.w = pk_bf16(p1[6], p1[7]); pk[2] = __builtin_bit_cast(bf16x8, w);
                w.x = pk_bf16(p1[8], p1[9]); w.y = pk_bf16(p1[10], p1[11]); w.z = pk_bf16(p1[12], p1[13]); w.w = pk_bf16(p1[14], p1[15]); pk[3] = __builtin_bit_cast(bf16x8, w);
            }
            __builtin_amdgcn_sched_barrier(0);
            if (NDB == 4) {
                s16x4 lo2[2][4], hh2[2][4];
#pragma unroll
                for (int e = 0; e < 2; ++e)
#pragma unroll
                    for (int s = 0; s < 4; ++s) { lo2[e][s] = vtr(Vb + (2 + e) * 4096 + s * 1024); hh2[e][s] = vtr(Vb + (2 + e) * 4096 + s * 1024 + 512); }
                __builtin_amdgcn_sched_barrier(0);
#pragma unroll
                for (int s = 0; s < 4; ++s)
#pragma unroll
                    for (int e = 0; e < 2; ++e) {
                        const bf16x8 vf = (bf16x8){lo[e][s][0], lo[e][s][1], lo[e][s][2], lo[e][s][3], hh[e][s][0], hh[e][s][1], hh[e][s][2], hh[e][s][3]};
                        o[e] = __builtin_amdgcn_mfma_f32_32x32x16_bf16(vf, pk[s], o[e], 0, 0, 0);
                    }
                __builtin_amdgcn_sched_barrier(0);
#pragma unroll
                for (int s = 0; s < 4; ++s)
#pragma unroll
                    for (int e = 0; e < 2; ++e) {
                        const bf16x8 vf = (bf16x8){lo2[e][s][0], lo2[e][s][1], lo2[e][s][2], lo2[e][s][3], hh2[e][s][0], hh2[e][s][1], hh2[e][s][2], hh2[e][s][3]};
                        o[NDB - 2 + e] = __builtin_amdgcn_mfma_f32_32x32x16_bf16(vf, pk[s], o[NDB - 2 + e], 0, 0, 0);
                    }
            } else {
#pragma unroll
                for (int s = 0; s < 4; ++s)
#pragma unroll
                    for (int e = 0; e < 2; ++e) {
                        const bf16x8 vf = (bf16x8){lo[e][s][0], lo[e][s][1], lo[e][s][2], lo[e][s][3], hh[e][s][0], hh[e][s][1], hh[e][s][2], hh[e][s][3]};
                        o[e] = __builtin_amdgcn_mfma_f32_32x32x16_bf16(vf, pk[s], o[e], 0, 0, 0);
                    }
            }
            __builtin_amdgcn_sched_barrier(0);
        }
        st = (st == 2) ? 0 : st + 1; st2 = (st2 == 2) ? 0 : st2 + 1;
    }
#undef AT_DMA
    __syncthreads();
    const float inv = 1.0f / (l_run + __shfl_xor(l_run, 32));
    const size_t orow = (rowbase + qrow0 + r32) * DM;
    if (NMAP == 1) {
#pragma unroll
        for (int d = 0; d < NDB; ++d)
#pragma unroll
            for (int g = 0; g < 4; ++g) { u32x2 w; w.x = pk_bf16(o[d][4 * g] * inv, o[d][4 * g + 1] * inv); w.y = pk_bf16(o[d][4 * g + 2] * inv, o[d][4 * g + 3] * inv);
                *(u32x2*)(MIX + orow + 64 * h + 32 * d + 8 * g + 4 * hi) = w; }
        __syncthreads();
    } else {
        LAS float* ex = (LAS float*)(lds + AT_K) + (size_t)(wid & 3) * 4096 + lane;
        if (map == 1) {
#pragma unroll
            for (int d = 0; d < NDB; ++d)
#pragma unroll
                for (int r = 0; r < 16; ++r) ex[(d * 16 + r) * 64] = lam * (o[d][r] * inv);
        }
        __syncthreads();
        if (map == 0) {
            float ss = 0.f;
#pragma unroll
            for (int d = 0; d < NDB; ++d)
#pragma unroll
                for (int r = 0; r < 16; ++r) { const float v = o[d][r] * inv - ex[(d * 16 + r) * 64]; o[d][r] = v; ss += v * v; }
            ss += __shfl_xor(ss, 32);
            const float rn = outscale / sqrtf(ss * (1.0f / 128.0f) + EPS);
#pragma unroll
            for (int d = 0; d < NDB; ++d)
#pragma unroll
                for (int g = 0; g < 4; ++g) { const f32x4 gv = *(const f32x4*)(gn + 32 * d + 8 * g + 4 * hi);
                    u32x2 w; w.x = pk_bf16(o[d][4 * g] * rn * gv[0], o[d][4 * g + 1] * rn * gv[1]); w.y = pk_bf16(o[d][4 * g + 2] * rn * gv[2], o[d][4 * g + 3] * rn * gv[3]);
                    *(u32x2*)(MIX + orow + 512 + 128 * h + 32 * d + 8 * g + 4 * hi) = w; }
        }
        __syncthreads();
    }
}

__device__ __forceinline__ void attn_phase(const Args& a, int l, LAS unsigned char* lds, const int tid, const int rep) {
    const int lane = tid & 63;
    unsigned char* ws = a.ws;
    const bf16_t* U = (const bf16_t*)(ws + WS_U); bf16_t* MIX = (bf16_t*)(ws + WS_MIX); const float* logf = (const float*)(ws + WS_LOGF);
    unsigned* ctr = (unsigned*)(ws + WS_CTR) + l + 2 * rep;
    int lop = l; asm volatile("" : "+s"(lop));
    const float lam_init = 0.8f - 0.6f * expf(-0.3f * (float)lop);
    float lam;
    {
        const float* lv = a.in[10] + l * 256;
        const float sa = wave_sum(lv[lane] * lv[64 + lane]), sb = wave_sum(lv[128 + lane] * lv[192 + lane]);
        lam = expf(sa) - expf(sb) + lam_init;
    }
    const float* gn = a.in[11] + l * 128;
    volatile LAS unsigned* nextu = (volatile LAS unsigned*)(lds + AT_NEXT);
    for (;;) {
        if (tid == 0) *nextu = atomicAdd(ctr, 1u);
        __syncthreads();
        const unsigned i = *nextu;
        __syncthreads();
        if (i >= 1024u) break;
        if (i < 512u) {
            const int qb = 15 - (int)(i >> 5), bh = (int)(i & 31), b = bh >> 2, h = bh & 3;
            const float slope2 = exp2f(-2.0f * (float)(h + 1)) * LOG2E;
            attn_unit<128, 2>(lds, U, MIX, logf, b, h, qb, lam, slope2, gn, 1.0f - lam_init, tid);
        } else {
            const int j = (int)i - 512, qb = 7 - (j >> 6), bh = j & 63, b = bh >> 3, h = bh & 7;
            attn_unit<64, 1>(lds, U, MIX, logf, b, h, qb, 0.f, 0.f, gn, 1.f, tid);
        }
    }
}

#define XB_TMO      128
#define XB_XCNT(j)  (256  + 64 * (j))
#define XB_XSUB(j)  (1280 + 64 * (j))
#define XB_XGEN(j)  (2304 + 64 * (j))
#define XB_TOP      3328
#define XB_TOPGEN   3392
#define XCD_BAR_WORDS 3456
#define XB_SPIN_CAP (1u << 18)

__device__ __forceinline__ unsigned xb_ld(unsigned* p)              { return __hip_atomic_load(p, __ATOMIC_RELAXED, __HIP_MEMORY_SCOPE_AGENT); }
__device__ __forceinline__ unsigned xb_add(unsigned* p, unsigned v) { return __hip_atomic_fetch_add(p, v, __ATOMIC_RELAXED, __HIP_MEMORY_SCOPE_AGENT); }
__device__ __forceinline__ unsigned xb_xcc_id() { return (unsigned)__builtin_amdgcn_s_getreg((3 << 11) | 20) & 0xFu; }
#define XB_SPIN(cond, bar) do { unsigned _sp = 0; while (cond) { __builtin_amdgcn_s_sleep(1); \
    if ((++_sp & 255u) == 0u) { if (xb_ld(&(bar)[XB_TMO])) break; if (_sp > XB_SPIN_CAP) { atomicAdd(&(bar)[XB_TMO], 1u); break; } } } } while (0)

struct XcdBarrier {
    unsigned* bar; unsigned x;
    volatile LAS unsigned* st;
};

__device__ __forceinline__ XcdBarrier xcd_barrier_post(unsigned* bar, volatile LAS unsigned* st, const int tid) {
    XcdBarrier b; b.bar = bar; b.x = xb_xcc_id(); b.st = st;
    if (tid == 0) (void)xb_add(&bar[XB_XCNT(b.x)], 1u);
    return b;
}
__device__ __forceinline__ void xcd_barrier_complete(unsigned* bar, unsigned x, unsigned& nloc, unsigned& nx) {
    const unsigned G = gridDim.x * gridDim.y * gridDim.z;
    unsigned sum, cnt, mine, sp = 0u;
    for (;;) {
        sum = 0u; cnt = 0u; mine = 0u;
#pragma nounroll
        for (unsigned j = 0; j < 16; ++j) { const unsigned c = xb_ld(&bar[XB_XCNT(j)]); sum += c; cnt += (c > 0u) ? 1u : 0u; mine = (j == x) ? c : mine; }
        if (sum == G) break;
        __builtin_amdgcn_s_sleep(1);
        if ((++sp & 255u) == 0u) { if (xb_ld(&bar[XB_TMO])) break; if (sp > XB_SPIN_CAP) { atomicAdd(&bar[XB_TMO], 1u); break; } }
    }
    nloc = mine > 0u ? mine : 1u; nx = cnt > 0u ? cnt : 1u;
}

__device__ __forceinline__ void xcd_barrier(const XcdBarrier& b, const int tid) {
    asm volatile("s_waitcnt vmcnt(0)" ::: "memory");
    __syncthreads();
    if (tid == 0) {
        unsigned* bar = b.bar;
        __builtin_amdgcn_s_waitcnt(0);
        unsigned nloc = b.st[0], nx = b.st[1];
        if (nloc == 0u) { xcd_barrier_complete(bar, b.x, nloc, nx); b.st[0] = nloc; b.st[1] = nx; }
        const unsigned old = xb_add(&bar[XB_XSUB(b.x)], 1u);
        const unsigned gen = old / nloc;
        if (old + 1u == (gen + 1u) * nloc) {
            __builtin_amdgcn_fence(__ATOMIC_RELEASE, "agent");
            asm volatile("s_waitcnt vmcnt(0)" ::: "memory");
            const unsigned og = xb_add(&bar[XB_TOP], 1u);
            const unsigned tg = og / nx;
            if (og + 1u == (tg + 1u) * nx) xb_add(&bar[XB_TOPGEN], 1u);
            else XB_SPIN(xb_ld(&bar[XB_TOPGEN]) == tg, bar);
            __builtin_amdgcn_fence(__ATOMIC_ACQUIRE, "agent");
            xb_add(&bar[XB_XGEN(b.x)], 1u);
            asm volatile("s_waitcnt vmcnt(0)" ::: "memory");
        } else {
            XB_SPIN(xb_ld(&bar[XB_XGEN(b.x)]) == gen, bar);
            __builtin_amdgcn_fence(__ATOMIC_ACQUIRE, "agent");
            asm volatile("s_waitcnt vmcnt(0)" ::: "memory");
        }
    }
    __syncthreads();
}

#ifndef PROBE_DUP
#define PROBE_DUP 0
#endif
#ifndef PH_MASK
#define PH_MASK 255
#endif
__global__ void __launch_bounds__(512, 2) fwd_kernel(Args a) {
    extern __shared__ __attribute__((aligned(16))) unsigned char lds_raw[];
    LAS unsigned char* lds = (LAS unsigned char*)lds_raw;
    cg::grid_group grid = cg::this_grid();
    volatile LAS unsigned* bst = (volatile LAS unsigned*)(lds + LDS_BYTES - 64);
    const int wid_s = __builtin_amdgcn_readfirstlane((int)threadIdx.x >> 6);
    if (threadIdx.x < 2) bst[threadIdx.x] = 0u;
    __syncthreads();
    XcdBarrier xbar = xcd_barrier_post((unsigned*)(a.ws + WS_CTR + 4096), bst, (int)threadIdx.x);
    unsigned char* ws = a.ws;
    bf16_t* H = (bf16_t*)(ws + WS_H); bf16_t* U = (bf16_t*)(ws + WS_U); bf16_t* ABUF = (bf16_t*)(ws + WS_U);
    const float* mod = (const float*)(ws + WS_MOD); float* logf = (float*)(ws + WS_LOGF);
    for (int ph = a.ph_lo; ph < a.ph_hi; ++ph) {
        const int nrep = 1 + ((a.probe >> (ph < 2 ? 6 + ph : (ph - 2) % 5)) & 1);
#pragma nounroll
        for (int rep = 0; rep < nrep; ++rep) {
        int tidv = (wid_s << 6) | (int)__builtin_amdgcn_mbcnt_hi(~0u, __builtin_amdgcn_mbcnt_lo(~0u, 0u)); asm volatile("" : "+v"(tidv));
        if (rep == 1) __syncthreads();
        if (ph == 0) prep_phase(a, lds, tidv);
        else if (ph == 1) norm0_phase(a, lds, tidv);
        else {
            const int l = (ph - 2) / 5, s = (ph - 2) % 5;
            const float* modl = mod + (size_t)l * 8 * MODW;
            float* rowss = (float*)(ws + WS_ROWSS); const float* gs = (const float*)(ws + WS_GS);
            if (s == 0) { pg8::Gemm g{H, (const bf16_t*)(ws + WS_WIN) + (size_t)l * UW * 1024, MT, UW, 1024}; pg8::StaticOrder S; S.init(MT, UW, (int)gridDim.x, (int)blockIdx.x);
                pg8::EpiIn E{U, a.in[8] + l * 128, a.in[9] + l * 128, pg8::Prefetch{S, rowss + (size_t)(2 * l) * MT * 4, (const float*)(ws + WS_SHW1) + (size_t)l * 8 * UW, UW, lds + PF_OFF}, 0};
                E.P.issue(0, (tidv >> 6) == 0, tidv & 63); pg8::gemm_phase<pg8::EpiIn, pg8::StaticOrder, true, true>(lds, g, S, E, tidv);
                fg_tail(a, l, lds, tidv); if (a.probe & 1024) fg_tail(a, l, lds, tidv); }
            else if (s == 1) attn_phase(a, l, lds, tidv, rep);
            else if (s == 2) { pg8::Gemm g{(const bf16_t*)(ws + WS_MIX), (const bf16_t*)(ws + WS_WOUT) + (size_t)l * 1024 * 1024, MT, 1024, 1024}; pg8::StaticOrder S; S.init(MT, 1024, (int)gridDim.x, (int)blockIdx.x);
                bf16_t* XB = (bf16_t*)(ws + WS_XB); pg8::EpiRes E{l == 0 ? a.in[0] : nullptr, l == 0 ? nullptr : XB, nullptr, XB, modl + 2048, H, gs + (size_t)(2 * l + 1) * 8 * 1024, rowss + (size_t)(2 * l + 1) * MT * 4, (LAS float*)(lds + RED_OFF)}; pg8::gemm_phase<pg8::EpiRes, pg8::StaticOrder, true, true>(lds, g, S, E, tidv); }
            else if (s == 3) { pg8::Gemm g{H, (const bf16_t*)(ws + WS_WGU) + (size_t)l * 2 * FF * 1024, MT, 2 * FF, 1024}; pg8::StaticOrder S; S.init(MT, 2 * FF, (int)gridDim.x, (int)blockIdx.x);
                pg8::EpiGU E{ABUF, pg8::Prefetch{S, rowss + (size_t)(2 * l + 1) * MT * 4, (const float*)(ws + WS_SHW2) + (size_t)l * 8 * 2 * FF, 2 * FF, lds + PF_OFF}, 0};
                E.P.issue(0, (tidv >> 6) == 0, tidv & 63); pg8::gemm_phase<pg8::EpiGU, pg8::StaticOrder, true, true>(lds, g, S, E, tidv);
                if (l == 0) {
                    const int rem = S.nwg % S.G, nidle = rem == 0 ? S.G : S.G - rem, me = rem == 0 ? S.c : S.c - rem;
                    if (me >= 0) { int tv3 = tidv; asm volatile("" : "+v"(tv3)); shw_tables(a, 2, 4, me * 8 + (tv3 >> 6), nidle * 8, tv3 & 63); weight_items(a, lds, tv3, 1); }
                } }
            else { const bool nxt = l + 1 < DEPTH; pg8::Gemm g{ABUF, (const bf16_t*)(ws + WS_WD) + (size_t)l * 1024 * FF, MT, 1024, FF}; pg8::StaticOrder S; S.init(MT, 1024, (int)gridDim.x, (int)blockIdx.x);
                bf16_t* XB = (bf16_t*)(ws + WS_XB); pg8::EpiRes E{nullptr, XB, nxt ? nullptr : a.out, nxt ? XB : nullptr, modl + 5120, nxt ? H : nullptr, gs + (size_t)(2 * l + 2) * 8 * 1024, rowss + (size_t)(2 * l + 2) * MT * 4, (LAS float*)(lds + RED_OFF)}; pg8::gemm_phase<pg8::EpiRes, pg8::StaticOrder, true, true>(lds, g, S, E, tidv); }
        }
        }
        if (ph + 1 < a.ph_hi) { const int tb = (wid_s << 6) | (int)__builtin_amdgcn_mbcnt_hi(~0u, __builtin_amdgcn_mbcnt_lo(~0u, 0u)); if (a.probe & 512) grid.sync(); else xcd_barrier(xbar, tb); if (a.probe & 256) xcd_barrier(xbar, tb); }
    }
}

#ifndef MK_ONE_LAUNCH
#define MK_ONE_LAUNCH 1
#endif
extern "C" void kernel_launch(void* const* d_in, const int* in_sizes, int n_in, void* d_out, int out_size, void* d_ws, size_t ws_size, hipStream_t stream) {
    static int grid = 0;
    if (grid == 0) {
        if (n_in != 16 || out_size != MT * DM || ws_size < WS_END) { fprintf(stderr, "kernel_launch: unexpected shapes (n_in %d out %d ws %zu)\n", n_in, out_size, ws_size); grid = -1; return; }
        int dev = 0, cus = 0, per_cu = 0;
        (void)hipGetDevice(&dev);
        (void)hipDeviceGetAttribute(&cus, hipDeviceAttributeMultiprocessorCount, dev);
        if (hipFuncSetAttribute((const void*)fwd_kernel, hipFuncAttributeMaxDynamicSharedMemorySize, LDS_BYTES) != hipSuccess) { fprintf(stderr, "kernel_launch: hipFuncSetAttribute failed\n"); grid = -1; return; }
        if (hipOccupancyMaxActiveBlocksPerMultiprocessor(&per_cu, (const void*)fwd_kernel, 512, LDS_BYTES) != hipSuccess || per_cu < 1) { fprintf(stderr, "kernel_launch: occupancy query gave %d\n", per_cu); per_cu = 1; }
        (void)hipGetLastError();
        grid = cus * (per_cu > 1 ? 1 : per_cu);
        if (grid <= 0) grid = 256;
    }
    if (grid < 0) return;
    Args a{};
    for (int i = 0; i < 16; ++i) a.in[i] = (const float*)d_in[i];
    a.out = (float*)d_out; a.ws = (unsigned char*)d_ws; a.probe = PROBE_DUP;
    (void)hipMemsetAsync((char*)d_ws + WS_CTR, 0, CTL_ZERO_BYTES, stream);
#if MK_ONE_LAUNCH
    a.ph_lo = 0; a.ph_hi = NPHASE;
    void* args[] = {&a};
    hipError_t e = hipLaunchCooperativeKernel((const void*)fwd_kernel, dim3(grid), dim3(512), args, LDS_BYTES, stream);
    if (e != hipSuccess) fprintf(stderr, "cooperative launch failed: %s (grid %d)\n", hipGetErrorString(e), grid);
#else
    for (int ph = 0; ph < NPHASE; ++ph) { a.ph_lo = ph; a.ph_hi = ph + 1; hipLaunchKernelGGL(fwd_kernel, dim3(grid), dim3(512), LDS_BYTES, stream, a); }
#endif
}
```
